# Optimizing an MI355X kernel written in HIP

```python
import jax, jax.numpy as jnp
from jax import lax
import numpy as np

D_MODEL = 1024
BATCH = 4
SEQ = 8192
DEPTH = 1

CHUNK = 64
EPS = 1e-6
RET_HEADS = 4
RET_DK = 64
RET_DV = 128
RET_THETA = 10000.0
DSA_HEADS = 8
DSA_DH = 64
IDX_HEADS = 4
IDX_DH = 64
DSA_TOPK_MAX = 256
Q_BLOCK = 128
ROPE_THETA = 500000.0
ROPE_DIM = DSA_DH // 4
PEER_HEADS = 8
PEER_NKEYS = 128
PEER_N_EXPERTS = PEER_NKEYS * PEER_NKEYS
PEER_DKEY = 256
PEER_TOPK = 16
PEER_BLOCK = 128
RET_QK = RET_HEADS * RET_DK
RET_V = RET_HEADS * RET_DV
DSA_W = DSA_HEADS * DSA_DH
IDX_Q = IDX_HEADS * IDX_DH
N_BRANCH = 2
IN_SIZES = (RET_QK, RET_QK, RET_V, RET_V, DSA_W, DSA_W, DSA_W, IDX_Q, IDX_DH, IDX_HEADS, N_BRANCH * D_MODEL)
D_IN = 2 * RET_QK + 2 * RET_V + 3 * DSA_W + IDX_Q + IDX_DH + IDX_HEADS + N_BRANCH * D_MODEL

kernel_name = "hybrid_retention_dsa_peer_block"


def rms_norm(x, g):
    xf = x.astype(jnp.float32)
    y = xf * lax.rsqrt(jnp.mean(xf * xf, axis=-1, keepdims=True) + EPS)
    return (y * g.astype(jnp.float32)).astype(x.dtype)


def rope(x, pos, rot_dim, theta):
    half = rot_dim // 2
    inv = theta ** (-jnp.arange(half, dtype=jnp.float32) / half)
    ang = pos.astype(jnp.float32)[:, None] * inv[None, :]
    cos = jnp.cos(ang)[None, :, None, :]
    sin = jnp.sin(ang)[None, :, None, :]
    xr = x[..., :rot_dim].astype(jnp.float32)
    x1, x2 = xr[..., :half], xr[..., half:]
    rot = jnp.concatenate([x1 * cos - x2 * sin, x1 * sin + x2 * cos], axis=-1).astype(x.dtype)
    return jnp.concatenate([rot, x[..., rot_dim:]], axis=-1)


def split_cols(a, sizes):
    outs, off = [], 0
    for s in sizes:
        outs.append(a[..., off:off + s])
        off += s
    return outs


def retention(q, k, v, gate, gn):
    f32 = jnp.float32
    B, L, H, dk = q.shape
    dv = v.shape[-1]
    C = CHUNK
    NC = L // C
    log_g = jnp.log(1.0 - 2.0 ** (-5.0 - jnp.arange(H, dtype=f32)))
    i = jnp.arange(C, dtype=f32)
    qc = q.astype(f32).reshape(B, NC, C, H, dk) * (dk ** -0.5)
    kc = k.astype(f32).reshape(B, NC, C, H, dk)
    vc = v.astype(f32).reshape(B, NC, C, H, dv)
    intra_decay = jnp.exp(log_g[:, None, None] * jnp.abs(i[:, None] - i[None, :]))
    scores = jnp.einsum('bnihd,bnjhd->bnhij', qc, kc) * intra_decay
    intra = jnp.einsum('bnhij,bnjhe->bnihe', scores, vc)
    k_decay = jnp.exp(log_g[None, :] * (C - 1 - i)[:, None])
    kv = jnp.einsum('bnjhd,bnjhe->nbhde', kc * k_decay[:, :, None], vc)
    chunk_decay = jnp.exp(log_g * C)[None, :, None, None]

    def step(state, kv_n):
        return chunk_decay * state + kv_n, state

    _, prev = lax.scan(step, jnp.zeros_like(kv[0]), kv)
    q_decay = jnp.exp(log_g[None, :] * (i + 1.0)[:, None])
    cross = jnp.einsum('bnihd,nbhde->bnihe', qc * q_decay[:, :, None], prev)
    y = (intra + cross).reshape(B, L, H, dv)
    mu = jnp.mean(y, axis=-1, keepdims=True)
    var = jnp.mean(jnp.square(y - mu), axis=-1, keepdims=True)
    y = ((y - mu) * lax.rsqrt(var + EPS)).reshape(B, L, H * dv) * gn.astype(f32)
    return (jax.nn.swish(gate.astype(f32)) * y).astype(gate.dtype)


def dsa_attention(q, k, v, q_idx, k_idx, w_idx, topk):
    f32 = jnp.float32
    B, L, H, dh = q.shape
    NB = L // Q_BLOCK
    key_chunk = jnp.arange(L) // CHUNK

    def to_blocks(a):
        return jnp.moveaxis(a.reshape(B, NB, Q_BLOCK, *a.shape[2:]), 1, 0)

    def block(args):
        qb, qib, wb, qpos = args
        qchunk = qpos // CHUNK
        admissible = key_chunk[None, :] <= qchunk[:, None]
        rel = jax.nn.relu(jnp.einsum('bqhd,bsd->bqhs', qib, k_idx).astype(f32))
        iscore = jnp.einsum('bqhs,bqh->bqs', rel, wb.astype(f32))
        iscore = jnp.where(admissible[None], iscore, -jnp.inf)
        _, sel = lax.top_k(iscore, topk)
        valid = (sel // CHUNK) <= qchunk[None, :, None]
        k_sel = jax.vmap(lambda kb, ib: kb[ib])(k, sel)
        v_sel = jax.vmap(lambda vb, ib: vb[ib])(v, sel)
        logits = jnp.einsum('bqhd,bqkhd->bhqk', qb, k_sel).astype(f32) * (dh ** -0.5)
        logits = jnp.where(valid[:, None], logits, -jnp.inf)
        p = jax.nn.softmax(logits, axis=-1).astype(v.dtype)
        return jnp.einsum('bhqk,bqkhd->bqhd', p, v_sel)

    qpos = jnp.arange(L).reshape(NB, Q_BLOCK)
    out = lax.map(block, (to_blocks(q), to_blocks(q_idx), to_blocks(w_idx), qpos))
    return jnp.moveaxis(out, 0, 1).reshape(B, L, H * dh)


def peer_ffn(h, w_q, sub_keys, u_tab, v_tab):
    f32 = jnp.float32
    B, L, D = h.shape
    T = PEER_BLOCK
    K = PEER_TOPK
    tokens = h.reshape(-1, T, D)

    def block(xb):
        q = (xb @ w_q).reshape(T, PEER_HEADS, 2, PEER_DKEY // 2)
        s = jnp.einsum('thcd,hckd->thck', q, sub_keys).astype(f32)
        s_top, i_top = lax.top_k(s, K)
        cand = s_top[:, :, 0, :, None] + s_top[:, :, 1, None, :]
        cand_idx = i_top[:, :, 0, :, None] * PEER_NKEYS + i_top[:, :, 1, None, :]
        best, pos = lax.top_k(cand.reshape(T, PEER_HEADS, K * K), K)
        expert = jnp.take_along_axis(cand_idx.reshape(T, PEER_HEADS, K * K), pos, axis=-1)
        g = jax.nn.softmax(best, axis=-1)
        u_sel = u_tab[expert]
        a = jax.nn.gelu(jnp.einsum('thkd,td->thk', u_sel, xb).astype(f32), approximate=False)
        return jnp.einsum('thk,thkd->td', (g * a).astype(xb.dtype), v_tab[expert])

    return lax.map(block, tokens).reshape(B, L, D)


def setup_inputs(seed: int = 0) -> dict:
    key = jax.random.key(seed)
    ks = jax.random.split(key, 16)
    D = D_MODEL
    nrm = lambda k, shape, scale: jax.random.normal(k, shape, jnp.float32) * scale
    return {
        "x": nrm(ks[0], (BATCH, SEQ, D), 1.0),
        "attn_norm": 1.0 + nrm(ks[1], (DEPTH, D), 0.01),
        "w_in": nrm(ks[2], (DEPTH, D, D_IN), D ** -0.5),
        "ret_gn": 1.0 + nrm(ks[3], (DEPTH, RET_V), 0.01),
        "w_ret_o": nrm(ks[4], (DEPTH, RET_V, D), RET_V ** -0.5),
        "w_dsa_o": nrm(ks[5], (DEPTH, DSA_W, D), DSA_W ** -0.5),
        "w_out": nrm(ks[6], (DEPTH, D, D), D ** -0.5),
        "ffn_norm": 1.0 + nrm(ks[7], (DEPTH, D), 0.01),
        "peer_wq": nrm(ks[8], (DEPTH, D, PEER_HEADS * PEER_DKEY), D ** -0.5),
        "peer_subkeys": nrm(ks[9], (DEPTH, PEER_HEADS, 2, PEER_NKEYS, PEER_DKEY // 2), (PEER_DKEY // 2) ** -0.5),
        "peer_u": nrm(ks[10], (DEPTH, PEER_N_EXPERTS, D), D ** -0.5),
        "peer_v": nrm(ks[11], (DEPTH, PEER_N_EXPERTS, D), PEER_HEADS ** -0.5),
        "final_norm": 1.0 + nrm(ks[12], (D,), 0.01),
    }


def reference(x, attn_norm, w_in, ret_gn, w_ret_o, w_dsa_o, w_out, ffn_norm, peer_wq, peer_subkeys, peer_u, peer_v, final_norm):
    B, L, D = x.shape
    pos = jnp.arange(L)
    topk = min(DSA_TOPK_MAX, L // 4)
    for layer in range(DEPTH):
        h = rms_norm(x, attn_norm[layer])
        proj = h @ w_in[layer]
        (rq, rk, rv, rg, dq, dk, dv, iq, ik, iw, gates) = split_cols(proj, IN_SIZES)
        rq = rope(rq.reshape(B, L, RET_HEADS, RET_DK), pos, RET_DK, RET_THETA)
        rk = rope(rk.reshape(B, L, RET_HEADS, RET_DK), pos, RET_DK, RET_THETA)
        y_ret = retention(rq, rk, rv.reshape(B, L, RET_HEADS, RET_DV), rg, ret_gn[layer])
        dq = rope(dq.reshape(B, L, DSA_HEADS, DSA_DH), pos, ROPE_DIM, ROPE_THETA)
        dk = rope(dk.reshape(B, L, DSA_HEADS, DSA_DH), pos, ROPE_DIM, ROPE_THETA)
        iq = rope(iq.reshape(B, L, IDX_HEADS, IDX_DH), pos, IDX_DH // 4, ROPE_THETA)
        ik = rope(ik.reshape(B, L, 1, IDX_DH), pos, IDX_DH // 4, ROPE_THETA).reshape(B, L, IDX_DH)
        iw = iw * ((IDX_HEADS ** -0.5) * (IDX_DH ** -0.5))
        y_dsa = dsa_attention(dq, dk, dv.reshape(B, L, DSA_HEADS, DSA_DH), iq, ik, iw, topk)
        g_ret, g_dsa = split_cols(jax.nn.sigmoid(gates), (D, D))
        merged = g_ret * (y_ret @ w_ret_o[layer]) + g_dsa * (y_dsa @ w_dsa_o[layer])
        x = x + merged @ w_out[layer]
        h2 = rms_norm(x, ffn_norm[layer])
        x = x + peer_ffn(h2, peer_wq[layer], peer_subkeys[layer], peer_u[layer], peer_v[layer])
    return rms_norm(x, final_norm)
```

```cpp
#include <hip/hip_runtime.h>
#include <hip/hip_bf16.h>
#include <cstdio>
#include <cstdint>
#include <cmath>

#define LAS __attribute__((address_space(3)))
#define GAS __attribute__((address_space(1)))
typedef unsigned short u16;
typedef short bf16x8 __attribute__((ext_vector_type(8)));
typedef _Float16 f16x8 __attribute__((ext_vector_type(8)));
typedef _Float16 f16x4 __attribute__((ext_vector_type(4)));
typedef float f32x2 __attribute__((ext_vector_type(2)));
typedef float f32x4 __attribute__((ext_vector_type(4)));
typedef float f32x16 __attribute__((ext_vector_type(16)));
typedef unsigned u32x2 __attribute__((ext_vector_type(2)));
typedef unsigned u32x4 __attribute__((ext_vector_type(4)));
typedef short s16x4 __attribute__((ext_vector_type(4)));
typedef unsigned short u16x2 __attribute__((ext_vector_type(2)));
typedef __bf16 bf16x2v __attribute__((ext_vector_type(2)));

constexpr int NTOK = 32768, SEQ = 8192, NBATCH = 4, DMODEL = 1024;
constexpr int D_IN = 5444;
constexpr int N1PAD = 5632;
constexpr float EPS = 1e-6f;
constexpr float C2 = 0.125f * 1.4426950408889634f;
constexpr int NWAVES = 8;

constexpr size_t MiB = 1u << 20;
constexpr size_t WS_CTL = 0, CTL_ZERO_BYTES = 32768;
constexpr size_t WS_WIN = 1 * MiB;
constexpr size_t WS_WRO = 12 * MiB;
constexpr size_t WS_WDO = 13 * MiB;
constexpr size_t WS_WOUT = 14 * MiB;
constexpr size_t WS_WSC = 16 * MiB;
constexpr size_t WS_U = 20 * MiB;
constexpr size_t WS_V = 52 * MiB;
constexpr size_t WS_TABA = 84 * MiB;
constexpr size_t WS_TABB = 86 * MiB;
constexpr size_t WS_IW = 87 * MiB;
constexpr size_t WS_KUV = 87 * MiB + 768 * 1024;
constexpr size_t WS_RSTD = 87 * MiB + 896 * 1024;
constexpr size_t WS_XB = 428 * MiB;
constexpr size_t WS_YRET = 88 * MiB;
constexpr size_t WS_YDSA = 120 * MiB;
constexpr size_t WS_RQ = 152 * MiB;
constexpr size_t WS_RK = 168 * MiB;
constexpr size_t WS_RV = 184 * MiB;
constexpr size_t WS_RG = 216 * MiB;
constexpr size_t WS_DQ = 248 * MiB;
constexpr size_t WS_DK = 280 * MiB;
constexpr size_t WS_DV = 312 * MiB;
constexpr size_t WS_IQ = 344 * MiB;
constexpr size_t WS_IK = 360 * MiB;
constexpr size_t WS_GATES = 364 * MiB;
constexpr size_t WS_MERGED = 152 * MiB;
constexpr size_t WS_X1B = 216 * MiB;
constexpr size_t WS_SC = 364 * MiB;
constexpr size_t WS_END = 492 * MiB;
constexpr size_t OUT_KV = 0, OUT_BM = 64 * MiB;

#define RLX_AGENT __ATOMIC_RELAXED, __HIP_MEMORY_SCOPE_AGENT
#define LDS_WAIT() asm volatile("s_waitcnt lgkmcnt(0)" ::: "memory")
#define VM_WAIT() asm volatile("s_waitcnt vmcnt(0)" ::: "memory")
__device__ __forceinline__ unsigned cvt_pk_bf16(float lo, float hi) { unsigned r; asm volatile("v_cvt_pk_bf16_f32 %0, %1, %2" : "=v"(r) : "v"(lo), "v"(hi)); return r; }
__device__ __forceinline__ unsigned f2bf(float f) { unsigned u = __builtin_bit_cast(unsigned, f); return (u + 0x7fffu + ((u >> 16) & 1u)) >> 16; }
__device__ __forceinline__ float bf2f(unsigned b) { return __builtin_bit_cast(float, b << 16); }
__device__ __forceinline__ unsigned pk_f16(float lo, float hi) { _Float16 a = (_Float16)lo, b = (_Float16)hi; return (unsigned)__builtin_bit_cast(u16, a) | ((unsigned)__builtin_bit_cast(u16, b) << 16); }
template <int CTRL> __device__ __forceinline__ int dppi(int x) { return __builtin_amdgcn_mov_dpp(x, CTRL, 0xf, 0xf, true); }
template <int CTRL> __device__ __forceinline__ float dppf(float x) { return __builtin_bit_cast(float, __builtin_amdgcn_mov_dpp(__builtin_bit_cast(int, x), CTRL, 0xf, 0xf, true)); }
__device__ __forceinline__ float row16_sum(float v) { v += dppf<0xB1>(v); v += dppf<0x4E>(v); v += dppf<0x141>(v); v += dppf<0x128>(v); return v; }
__device__ __forceinline__ float row16_max(float v) { v = fmaxf(v, dppf<0xB1>(v)); v = fmaxf(v, dppf<0x4E>(v)); v = fmaxf(v, dppf<0x141>(v)); v = fmaxf(v, dppf<0x128>(v)); return v; }
__device__ __forceinline__ unsigned row16_maxu(unsigned v) {
    unsigned t;
    t = (unsigned)dppi<0xB1>((int)v); v = v > t ? v : t; t = (unsigned)dppi<0x4E>((int)v); v = v > t ? v : t;
    t = (unsigned)dppi<0x141>((int)v); v = v > t ? v : t; t = (unsigned)dppi<0x128>((int)v); v = v > t ? v : t; return v; }
__device__ __forceinline__ float wave_sum(float v) {
    v = row16_sum(v);
    { auto r = __builtin_amdgcn_permlane16_swap(__float_as_uint(v), __float_as_uint(v), false, false); const unsigned r0 = r[0], r1 = r[1]; v = __uint_as_float(r0) + __uint_as_float(r1); }
    { auto r = __builtin_amdgcn_permlane32_swap(__float_as_uint(v), __float_as_uint(v), false, false); const unsigned r0 = r[0], r1 = r[1]; v = __uint_as_float(r0) + __uint_as_float(r1); }
    return v; }
__device__ __forceinline__ int wave_sum_i(int v) {
    v += dppi<0xB1>(v); v += dppi<0x4E>(v); v += dppi<0x141>(v); v += dppi<0x128>(v);
    { auto r = __builtin_amdgcn_permlane16_swap((unsigned)v, (unsigned)v, false, false); const unsigned r0 = r[0], r1 = r[1]; v = (int)(r0 + r1); }
    { auto r = __builtin_amdgcn_permlane32_swap((unsigned)v, (unsigned)v, false, false); const unsigned r0 = r[0], r1 = r[1]; v = (int)(r0 + r1); }
    return v; }
__device__ __forceinline__ float wave_max(float v) {
    v = row16_max(v);
    { auto r = __builtin_amdgcn_permlane16_swap(__float_as_uint(v), __float_as_uint(v), false, false); const unsigned r0 = r[0], r1 = r[1]; v = fmaxf(__uint_as_float(r0), __uint_as_float(r1)); }
    { auto r = __builtin_amdgcn_permlane32_swap(__float_as_uint(v), __float_as_uint(v), false, false); const unsigned r0 = r[0], r1 = r[1]; v = fmaxf(__uint_as_float(r0), __uint_as_float(r1)); }
    return v; }
struct __attribute__((packed, aligned(4))) U3 { unsigned x, y, z; };
__device__ __forceinline__ unsigned fp6_code(float x) {
    const float a = fabsf(x);
    const unsigned bits = __float_as_uint(a);
    const unsigned rn = (bits + 0x7FFFFu + ((bits >> 20) & 1u)) >> 20;
    const int cn = (int)rn - 1008;
    const int cs = (int)__builtin_rintf(a * 8.0f);
    int c = a >= 1.0f ? cn : cs; c = c > 31 ? 31 : c;
    return (unsigned)c | (x < 0.f ? 32u : 0u);
}
__device__ __forceinline__ float sigmoidf_(float x) { return __builtin_amdgcn_rcpf(1.0f + __builtin_amdgcn_exp2f(-1.4426950408889634f * x)); }
__device__ __forceinline__ float gelu_erf(float v) {
    const float av = fabsf(v), t = __builtin_amdgcn_rcpf(av * 0.2316418882f + 1.0f);
    float q = t * 0.5307027145f + (-0.7265760135f); q = q * t + 0.7107068705f; q = q * t + (-0.142248368f); q = q * t + 0.127414796f; q = q * t;
    const float e = __builtin_amdgcn_exp2f((v * v) * (-0.72134752044f));
    const float m = v * (q * e);
    return v < 0.f ? m : v - m;
}

namespace pg8 {
typedef u16 bf16_t;
constexpr int BM = 256, BK = 64, HALF = 128, HTB = HALF * BK * 2, STAGE_BYTES = 8 * HTB, NXCD = 8, WGM = 8;
__host__ __device__ __forceinline__ int lds_byte(int r, int c) { const int st = (r >> 4) * 2 + (c >> 5), rr = r & 15, cc = c & 31, ob = rr * 64 + cc * 2; return st * 1024 + (ob ^ (((ob >> 9) & 1) << 5)); }
__host__ __device__ __forceinline__ void stage_rc(int b, int& R, int& C) { const int st = b / 1024, sb = b % 1024, swz = sb ^ (((sb >> 9) & 1) << 5); R = (st >> 1) * 16 + swz / 64; C = (st & 1) * 32 + (swz % 64) / 2; }
__host__ __device__ __forceinline__ int perm32(int rho) { const int n = rho >> 4, i = rho & 15; return 8 * (i >> 2) + 4 * n + (i & 3); }
struct Unit { int pm, pn, sub; };
enum Mode { M_PROJ = 0, M_MERGE = 1, M_OUT = 2, M_SCORE = 3 };
struct Desc {
    const bf16_t* A0; const bf16_t* B0; const bf16_t* A1; const bf16_t* B1;
    int K, nM, nN, nsub, G, c, mode;
    unsigned char* ws; const float* xin; float* out;
    __device__ __forceinline__ bool next(int i, Unit& u) const {
        const int ii = (nsub == 2) ? (i >> 1) : i; u.sub = (nsub == 2) ? (i & 1) : 0;
        const int nwg = nM * nN; const long L = (long)ii * G + c; if (L >= nwg) return false;
        int wgid = (int)L; { const int q = nwg / NXCD, r = nwg % NXCD, xcd = wgid % NXCD, off = wgid / NXCD; wgid = (xcd < r ? xcd * (q + 1) : r * (q + 1) + (xcd - r) * q) + off; }
        const int nig = WGM * nN, gid = wgid / nig, fm = gid * WGM, gsz = (nM - fm) < WGM ? (nM - fm) : WGM;
        u.pm = fm + ((wgid % nig) % gsz); u.pn = (wgid % nig) / gsz; return true;
    }
};

__device__ __forceinline__ u32x4 pack8_bf16(const f32x4 a, const f32x4 b) { u32x4 w; w.x = cvt_pk_bf16(a[0], a[1]); w.y = cvt_pk_bf16(a[2], a[3]); w.z = cvt_pk_bf16(b[0], b[1]); w.w = cvt_pk_bf16(b[2], b[3]); return w; }
__device__ __forceinline__ u32x4 pack8_f16(const f32x4 a, const f32x4 b) { u32x4 w; w.x = pk_f16(a[0], a[1]); w.y = pk_f16(a[2], a[3]); w.z = pk_f16(b[0], b[1]); w.w = pk_f16(b[2], b[3]); return w; }

__device__ __forceinline__ void epi_proj(const f32x4 (&acc)[2][2][4][2], const Unit& u, int wr, int wc, int fr, int fq, unsigned char* ws) {
    const int pn = u.pn;
    const int row0 = u.pm * BM + wr * 64 + fr;
    if (pn <= 1) {
        bf16_t* O = (bf16_t*)(ws + (pn == 0 ? WS_RQ : WS_RK)); const float sc = pn == 0 ? 0.125f : 1.0f;
        const f32x2* tab = (const f32x2*)(ws + WS_TABA);
#pragma unroll
        for (int ai = 0; ai < 2; ++ai)
#pragma unroll
            for (int m = 0; m < 4; ++m) {
                const int row = row0 + ai * HALF + m * 16; const int pos = row & (SEQ - 1);
                const f32x4* tp = (const f32x4*)(tab + pos * 32 + 8 * fq);
                const f32x4 t0 = tp[0], t1 = tp[1], t2 = tp[2], t3 = tp[3];
                const float cs[8] = {t0[0], t0[2], t1[0], t1[2], t2[0], t2[2], t3[0], t3[2]}, sn[8] = {t0[1], t0[3], t1[1], t1[3], t2[1], t2[3], t3[1], t3[3]};
                f32x4 o1a, o1b, o2a, o2b;
#pragma unroll
                for (int j = 0; j < 4; ++j) {
                    const float a0 = acc[ai][0][m][0][j], b0 = acc[ai][1][m][0][j], a1 = acc[ai][0][m][1][j], b1 = acc[ai][1][m][1][j];
                    o1a[j] = (a0 * cs[j] - b0 * sn[j]) * sc; o2a[j] = (a0 * sn[j] + b0 * cs[j]) * sc;
                    o1b[j] = (a1 * cs[4 + j] - b1 * sn[4 + j]) * sc; o2b[j] = (a1 * sn[4 + j] + b1 * cs[4 + j]) * sc; }
                bf16_t* rp = O + (size_t)row * 256 + wc * 64 + 8 * fq;
                *(u32x4*)rp = pack8_bf16(o1a, o1b); *(u32x4*)(rp + 32) = pack8_bf16(o2a, o2b);
            }
        return;
    }
    if (pn >= 14) {
        unsigned char* G8 = ws + WS_GATES;
#pragma unroll
        for (int ai = 0; ai < 2; ++ai)
#pragma unroll
            for (int m = 0; m < 4; ++m) { unsigned w[4];
#pragma unroll
                for (int bj = 0; bj < 2; ++bj)
#pragma unroll
                    for (int n = 0; n < 2; ++n) { unsigned pk = 0u;
#pragma unroll
                        for (int j = 0; j < 4; ++j) pk = __builtin_amdgcn_cvt_pk_u8_f32(255.0f * sigmoidf_(acc[ai][bj][m][n][j]), j, pk);
                        w[2 * bj + n] = pk; }
                *(u32x4*)(G8 + (size_t)(row0 + ai * HALF + m * 16) * 2048 + (pn - 14) * 256 + wc * 64 + fq * 16) = (u32x4){w[0], w[1], w[2], w[3]}; }
        return;
    }
    if (pn == 2 || pn == 3 || pn == 10 || pn == 11 || pn == 4 || pn == 5) {
        bf16_t* O; int ldc, colt; int act = 0;
        if (pn <= 3) { O = (bf16_t*)(ws + WS_RV); ldc = 512; colt = (pn - 2) * 256; }
        else if (pn <= 5) { O = (bf16_t*)(ws + WS_RG); ldc = 512; colt = (pn - 4) * 256; act = 1; }
        else { O = (bf16_t*)(ws + WS_DV); ldc = 512; colt = (pn - 10) * 256; }
        const int col0 = colt + wc * 32 + 8 * fq;
#pragma unroll
        for (int ai = 0; ai < 2; ++ai)
#pragma unroll
            for (int m = 0; m < 4; ++m) { bf16_t* rowp = O + (size_t)(row0 + ai * HALF + m * 16) * ldc + col0;
#pragma unroll
                for (int bj = 0; bj < 2; ++bj) { f32x4 v0 = acc[ai][bj][m][0], v1 = acc[ai][bj][m][1];
                    if (act == 1) {
#pragma unroll
                        for (int j = 0; j < 4; ++j) { v0[j] = v0[j] * sigmoidf_(v0[j]); v1[j] = v1[j] * sigmoidf_(v1[j]); } }
                    *(u32x4*)(rowp + bj * HALF) = pack8_bf16(v0, v1); } }
        return;
    }
    if (pn == 13) {
        _Float16* OK = (_Float16*)(ws + WS_IK); float* OW = (float*)(ws + WS_IW);
        const f32x2* tab = (const f32x2*)(ws + WS_TABB);
        if (wc > 2) return;
#pragma unroll
        for (int ai = 0; ai < 2; ++ai)
#pragma unroll
            for (int m = 0; m < 4; ++m) {
                const int row = row0 + ai * HALF + m * 16; const int pos = row & (SEQ - 1);
                f32x4 v0 = acc[ai][0][m][0], v1 = acc[ai][0][m][1];
                if (wc == 2) { if (fq == 0) { *(f32x4*)(OW + (size_t)row * 4) = v0 * 0.0625f; } continue; }
                _Float16* tp_ = OK + (size_t)(row >> 5) * 2048 + (row & 31) * 8;
                if (wc == 0 && fq < 2) {
                    const f32x4* tp = (const f32x4*)(tab + pos * 8 + 4 * fq); const f32x4 t0 = tp[0], t1 = tp[1];
                    const float cs[4] = {t0[0], t0[2], t1[0], t1[2]}, sn[4] = {t0[1], t0[3], t1[1], t1[3]};
                    f32x4 o1, o2;
#pragma unroll
                    for (int j = 0; j < 4; ++j) { o1[j] = v0[j] * cs[j] - v1[j] * sn[j]; o2[j] = v0[j] * sn[j] + v1[j] * cs[j]; }
                    u32x2 w1, w2; w1.x = pk_f16(o1[0], o1[1]); w1.y = pk_f16(o1[2], o1[3]); w2.x = pk_f16(o2[0], o2[1]); w2.y = pk_f16(o2[2], o2[3]);
                    *(u32x2*)(tp_ + 4 * fq) = w1; *(u32x2*)(tp_ + 256 + 4 * fq) = w2;
                } else { const int c = 4 * wc + fq; *(u32x4*)(tp_ + (c >> 1) * 512 + (c & 1) * 256) = pack8_f16(v0, v1); }
            }
        return;
    }
    {
        const bool f16o = (pn == 12);
        bf16_t* O; int ldc, colt; float sc = 1.0f;
        if (pn <= 7) { O = (bf16_t*)(ws + WS_DQ); ldc = 512; colt = (pn - 6) * 256; sc = C2; }
        else if (pn <= 9) { O = (bf16_t*)(ws + WS_DK); ldc = 512; colt = (pn - 8) * 256; }
        else { O = (bf16_t*)(ws + WS_IQ); ldc = 256; colt = 0; }
        const f32x2* tab = (const f32x2*)(ws + WS_TABB);
        const bool rot = ((wc & 1) == 0) && (fq < 2);
#pragma unroll
        for (int ai = 0; ai < 2; ++ai)
#pragma unroll
            for (int m = 0; m < 4; ++m) {
                const int row = row0 + ai * HALF + m * 16; const int pos = row & (SEQ - 1);
                f32x4 t0 = {1.f, 0.f, 1.f, 0.f}, t1 = {1.f, 0.f, 1.f, 0.f};
                if (rot) { const f32x4* tp = (const f32x4*)(tab + pos * 8 + 4 * fq); t0 = tp[0]; t1 = tp[1]; }
                const float cs[4] = {t0[0], t0[2], t1[0], t1[2]}, sn[4] = {t0[1], t0[3], t1[1], t1[3]};
#pragma unroll
                for (int bj = 0; bj < 2; ++bj) {
                    f32x4 v0 = acc[ai][bj][m][0] * sc, v1 = acc[ai][bj][m][1] * sc;
                    bf16_t* rp = O + (size_t)row * ldc + colt + bj * HALF + wc * 32;
                    if (rot) {
                        f32x4 o1, o2;
#pragma unroll
                        for (int j = 0; j < 4; ++j) { o1[j] = v0[j] * cs[j] - v1[j] * sn[j]; o2[j] = v0[j] * sn[j] + v1[j] * cs[j]; }
                        u32x2 w1, w2;
                        if (f16o) { w1.x = pk_f16(o1[0], o1[1]); w1.y = pk_f16(o1[2], o1[3]); w2.x = pk_f16(o2[0], o2[1]); w2.y = pk_f16(o2[2], o2[3]); }
                        else { w1.x = cvt_pk_bf16(o1[0], o1[1]); w1.y = cvt_pk_bf16(o1[2], o1[3]); w2.x = cvt_pk_bf16(o2[0], o2[1]); w2.y = cvt_pk_bf16(o2[2], o2[3]); }
                        *(u32x2*)(rp + 4 * fq) = w1; *(u32x2*)(rp + 8 + 4 * fq) = w2;
                    } else { *(u32x4*)(rp + 8 * fq) = f16o ? pack8_f16(v0, v1) : pack8_bf16(v0, v1); }
                }
            }
    }
}
__device__ __forceinline__ void epi_merge(f32x4 (&acc)[2][2][4][2], const Unit& u, int wr, int wc, int fr, int fq, unsigned char* ws) {
    const unsigned char* G8 = ws + WS_GATES; bf16_t* O = (bf16_t*)(ws + WS_MERGED);
    const int row0 = u.pm * BM + wr * 64 + fr, col0 = u.pn * BM + wc * 32 + 8 * fq;
    const int goff = wc * 64 + fq * 16;
    constexpr float K = 1.0f / 255.0f;
#pragma unroll
    for (int ai = 0; ai < 2; ++ai)
#pragma unroll
        for (int m = 0; m < 4; ++m) { const size_t row = (size_t)(row0 + ai * HALF + m * 16);
            const u32x4 gd = *(const u32x4*)(G8 + row * 2048 + (4 + u.pn) * 256 + goff);
            const unsigned gdw[4] = {gd.x, gd.y, gd.z, gd.w};
            if (u.sub == 0) {
                const u32x4 gr = *(const u32x4*)(G8 + row * 2048 + u.pn * 256 + goff);
                const unsigned grw[4] = {gr.x, gr.y, gr.z, gr.w};
#pragma unroll
                for (int bj = 0; bj < 2; ++bj)
#pragma unroll
                    for (int n = 0; n < 2; ++n)
#pragma unroll
                        for (int j = 0; j < 4; ++j) { const float d = (float)((gdw[2 * bj + n] >> (8 * j)) & 0xffu) * K, r = (float)((grw[2 * bj + n] >> (8 * j)) & 0xffu) * K;
                            acc[ai][bj][m][n][j] *= r * __builtin_amdgcn_rcpf(fmaxf(d, 1e-20f)); }
            } else {
#pragma unroll
                for (int bj = 0; bj < 2; ++bj) { f32x4 v0, v1;
#pragma unroll
                    for (int j = 0; j < 4; ++j) { v0[j] = acc[ai][bj][m][0][j] * fmaxf((float)((gdw[2 * bj] >> (8 * j)) & 0xffu) * K, 1e-20f); v1[j] = acc[ai][bj][m][1][j] * fmaxf((float)((gdw[2 * bj + 1] >> (8 * j)) & 0xffu) * K, 1e-20f); }
                    *(u32x4*)(O + row * 1024 + col0 + bj * HALF) = pack8_bf16(v0, v1); }
            } }
}
__device__ __forceinline__ void epi_out(const f32x4 (&acc)[2][2][4][2], const Unit& u, int wr, int wc, int fr, int fq, unsigned char* ws, const float* xin, float* out) {
    bf16_t* XB = (bf16_t*)(ws + WS_X1B); const bf16_t* XR = (const bf16_t*)(ws + WS_XB); (void)out; (void)xin;
    const int row0 = u.pm * BM + wr * 64 + fr, col0 = u.pn * BM + wc * 32 + 8 * fq;
#pragma unroll
    for (int ai = 0; ai < 2; ++ai)
#pragma unroll
        for (int m = 0; m < 4; ++m) { const size_t off = (size_t)(row0 + ai * HALF + m * 16) * 1024 + col0;
#pragma unroll
            for (int bj = 0; bj < 2; ++bj) { const u32x4 xr = *(const u32x4*)(XR + off + bj * HALF);
                const f32x4 x0 = {bf2f(xr.x & 0xffffu), bf2f(xr.x >> 16), bf2f(xr.y & 0xffffu), bf2f(xr.y >> 16)}, x1 = {bf2f(xr.z & 0xffffu), bf2f(xr.z >> 16), bf2f(xr.w & 0xffffu), bf2f(xr.w >> 16)};
                *(u32x4*)(XB + off + bj * HALF) = pack8_bf16(x0 + acc[ai][bj][m][0], x1 + acc[ai][bj][m][1]); } }
}
__device__ __forceinline__ void epi_score(const f32x4 (&acc)[2][2][4][2], const Unit& u, int wr, int wc, int fr, int fq, unsigned char* ws) {
    _Float16* O = (_Float16*)(ws + WS_SC);
    const int row0 = u.pm * BM + wr * 64 + fr, col0 = u.pn * BM + wc * 32 + 8 * fq;
#pragma unroll
    for (int ai = 0; ai < 2; ++ai)
#pragma unroll
        for (int m = 0; m < 4; ++m) { _Float16* rowp = O + (size_t)(row0 + ai * HALF + m * 16) * 2048 + col0;
#pragma unroll
            for (int bj = 0; bj < 2; ++bj) *(u32x4*)(rowp + bj * HALF) = pack8_f16(acc[ai][bj][m][0], acc[ai][bj][m][1]); }
}

__device__ __forceinline__ void gemm_phase(LAS unsigned char* lds, const Desc& S) {
    const int tid = threadIdx.x, wid = __builtin_amdgcn_readfirstlane(tid >> 6), lane = tid & 63, wr = wid >> 2, wc = wid & 3, fr = lane & 15, fq = lane >> 4;
    const int K = S.K, nt = K / BK;
    const bool PERM = true;
    unsigned voffA[2], voffB[2];
#pragma unroll
    for (int i = 0; i < 2; ++i) { int R, C; stage_rc(tid * 16 + i * 8192, R, C); const int Rb = PERM ? ((R & ~31) + perm32(R & 31)) : R;
        voffA[i] = (unsigned)(R * K + C) * 2u; voffB[i] = (unsigned)(Rb * K + C) * 2u; }
    const size_t kstep = (size_t)(BK * 2);
    const size_t hstep = (size_t)HALF * K * 2;
    const size_t tstep = 2 * hstep;
    const unsigned ldsw = (unsigned)wid * 1024u;
    const int aoff = lds_byte(wr * 64 + fr, fq * 8), boff = lds_byte(wc * 32 + fr, fq * 8);
#define PG8_SA(b, h) (((b) * 2 + (h)) * HTB)
#define PG8_SB(b, h) ((4 + (b) * 2 + (h)) * HTB)
#define PG8_STAGE(bufoff, gbase, voff) do { _Pragma("unroll") for (int _i = 0; _i < 2; ++_i) \
        __builtin_amdgcn_global_load_lds((const unsigned*)((const char*)(gbase) + (voff)[_i]), (LAS unsigned*)(lds + (bufoff) + ldsw + _i * 8192), 16, 0, 0); } while (0)
#define PG8_LDA(dst, b, h) do { _Pragma("unroll") for (int m = 0; m < 4; ++m) _Pragma("unroll") for (int k = 0; k < 2; ++k) dst[m][k] = *(const LAS bf16x8*)(lds + PG8_SA(b, h) + aoff + m * 2048 + k * 1024); } while (0)
#define PG8_LDB(dst, b, h) do { _Pragma("unroll") for (int n = 0; n < 2; ++n) _Pragma("unroll") for (int k = 0; k < 2; ++k) dst[n][k] = *(const LAS bf16x8*)(lds + PG8_SB(b, h) + boff + n * 2048 + k * 1024); } while (0)
#define PG8_MMA(ai, bj, At, Bt) do { __builtin_amdgcn_s_setprio(1); _Pragma("unroll") for (int m = 0; m < 4; ++m) _Pragma("unroll") for (int n = 0; n < 2; ++n) _Pragma("unroll") for (int k = 0; k < 2; ++k) \
        acc[ai][bj][m][n] = __builtin_amdgcn_mfma_f32_16x16x32_bf16(Bt[n][k], At[m][k], acc[ai][bj][m][n], 0, 0, 0); __builtin_amdgcn_s_setprio(0); } while (0)
#define PG8_WAIT_V(n) asm volatile("s_waitcnt vmcnt(" #n ")" ::: "memory")
#define PG8_WAIT_L(n) asm volatile("s_waitcnt lgkmcnt(" #n ")" ::: "memory")
#define PG8_BAR __builtin_amdgcn_s_barrier()
#define PG8_SCHED __builtin_amdgcn_sched_barrier(0)
#define PG8_UA(u) ((const char*)((u).sub ? S.A1 : S.A0) + (size_t)(u).pm * tstep)
#define PG8_UB(u) ((const char*)((u).sub ? S.B1 : S.B0) + (size_t)(u).pn * tstep)
    Unit cur, nxt; int ui = 0;
    if (!S.next(0, cur)) return;
    f32x4 acc[2][2][4][2];
#pragma unroll
    for (int a = 0; a < 2; ++a)
#pragma unroll
        for (int b = 0; b < 2; ++b)
#pragma unroll
            for (int m = 0; m < 4; ++m)
#pragma unroll
                for (int n = 0; n < 2; ++n) acc[a][b][m][n] = (f32x4){0.f, 0.f, 0.f, 0.f};
    bf16x8 At[4][2], B0[2][2], B1[2][2];
    const char* cA = PG8_UA(cur); const char* cB = PG8_UB(cur);
    PG8_STAGE(PG8_SB(0, 0), cB, voffB); PG8_STAGE(PG8_SB(0, 1), cB + hstep, voffB); PG8_STAGE(PG8_SA(0, 0), cA, voffA); PG8_STAGE(PG8_SA(0, 1), cA + hstep, voffA);
    if (wr == 1) PG8_BAR;
    PG8_WAIT_V(2); PG8_BAR;
    PG8_STAGE(PG8_SB(1, 0), cB + kstep, voffB); PG8_STAGE(PG8_SA(1, 0), cA + kstep, voffA); PG8_STAGE(PG8_SB(1, 1), cB + hstep + kstep, voffB);
    PG8_WAIT_V(6); PG8_BAR;
    for (;;) {
        const bool has_next = S.next(ui + 1, nxt);
        const char* nA = has_next ? PG8_UA(nxt) : cA; const char* nB = has_next ? PG8_UB(nxt) : cB;
        for (int t = 0; t < nt; t += 2) {
            const bool last = (t == nt - 2);
            const char* a1 = cA + (size_t)(t + 1) * kstep;
            const char* a2 = last ? nA : cA + (size_t)(t + 2) * kstep; const char* b2 = last ? nB : cB + (size_t)(t + 2) * kstep;
            const char* a3 = a2 + kstep; const char* b3 = b2 + kstep;
            PG8_LDB(B0, 0, 0); PG8_LDB(B1, 0, 1); PG8_SCHED; PG8_LDA(At, 0, 0); PG8_STAGE(PG8_SA(1, 1), a1 + hstep, voffA);
            PG8_WAIT_V(8); PG8_WAIT_L(0); PG8_BAR; PG8_MMA(0, 0, At, B0); PG8_MMA(0, 1, At, B1); PG8_BAR; PG8_SCHED;
            PG8_LDA(At, 0, 1); PG8_STAGE(PG8_SB(0, 0), b2, voffB); PG8_STAGE(PG8_SB(0, 1), b2 + hstep, voffB); PG8_STAGE(PG8_SA(0, 0), a2, voffA);
            PG8_WAIT_V(8); PG8_WAIT_L(0); PG8_BAR; PG8_MMA(1, 0, At, B0); PG8_MMA(1, 1, At, B1); PG8_BAR; PG8_SCHED;
            PG8_LDB(B0, 1, 0); PG8_LDB(B1, 1, 1); PG8_SCHED; PG8_LDA(At, 1, 0); PG8_STAGE(PG8_SA(0, 1), a2 + hstep, voffA);
            PG8_WAIT_V(8); PG8_WAIT_L(0); PG8_BAR; PG8_MMA(0, 0, At, B0); PG8_MMA(0, 1, At, B1); PG8_BAR; PG8_SCHED;
            PG8_LDA(At, 1, 1); PG8_STAGE(PG8_SB(1, 0), b3, voffB); PG8_STAGE(PG8_SB(1, 1), b3 + hstep, voffB); PG8_STAGE(PG8_SA(1, 0), a3, voffA);
            PG8_WAIT_V(8); PG8_WAIT_L(0); PG8_BAR; PG8_MMA(1, 0, At, B0); PG8_MMA(1, 1, At, B1); PG8_BAR; PG8_SCHED;
        }
        if (wr == 0) PG8_BAR;
        bool keep = false;
        if (S.mode == M_PROJ) {
            const float* RS = (const float*)(S.ws + WS_RSTD) + cur.pm * BM + wr * 64 + fr;
#pragma unroll
            for (int a = 0; a < 2; ++a)
#pragma unroll
                for (int m = 0; m < 4; ++m) { const float r = RS[a * HALF + m * 16];
#pragma unroll
                    for (int b = 0; b < 2; ++b)
#pragma unroll
                        for (int n = 0; n < 2; ++n) acc[a][b][m][n] *= r; }
            epi_proj(acc, cur, wr, wc, fr, fq, S.ws); }
        else if (S.mode == M_MERGE) { epi_merge(acc, cur, wr, wc, fr, fq, S.ws); keep = (cur.sub == 0); }
        else if (S.mode == M_OUT) epi_out(acc, cur, wr, wc, fr, fq, S.ws, S.xin, S.out);
        else epi_score(acc, cur, wr, wc, fr, fq, S.ws);
        if (!has_next) break;
        if (!keep) {
#pragma unroll
            for (int a = 0; a < 2; ++a)
#pragma unroll
                for (int b = 0; b < 2; ++b)
#pragma unroll
                    for (int m = 0; m < 4; ++m)
#pragma unroll
                        for (int n = 0; n < 2; ++n) acc[a][b][m][n] = (f32x4){0.f, 0.f, 0.f, 0.f};
        }
        cur = nxt; cA = nA; cB = nB; ++ui;
        if (wr == 1) PG8_BAR;
    }
    PG8_WAIT_V(0);
    PG8_BAR;
#undef PG8_SA
#undef PG8_SB
#undef PG8_STAGE
#undef PG8_LDA
#undef PG8_LDB
#undef PG8_MMA
#undef PG8_WAIT_V
#undef PG8_WAIT_L
#undef PG8_BAR
#undef PG8_SCHED
#undef PG8_UA
#undef PG8_UB
}
}

namespace attn_body {
using bf16 = __hip_bfloat16;
constexpr int NHEAD = 8, D = 64, DM = NHEAD * D;
constexpr int NW = 8, QBLK = 32, QB = QBLK * NW, KVBLK = 64, NQB = SEQ / QB;
__device__ __forceinline__ int crow(int r, int hi) { return (r & 3) + 8 * (r >> 2) + 4 * hi; }
#define SBAR() __builtin_amdgcn_sched_barrier(0)
constexpr int NSLOT = 3, SLOTB = 8192;
constexpr int LDS_K = 0, LDS_V = NSLOT * SLOTB, LDS_WS = 2 * NSLOT * SLOTB, LDS_OST = LDS_WS + NW * 64 * 4, LDS_M = LDS_OST + NW * 4096, LDS_TBL = LDS_M + NW * 2048, LDS_BYTES = LDS_TBL + 256;
__device__ __forceinline__ void glds16(const void* gsrc, unsigned lds_dst) { unsigned keep;
    asm volatile("s_mov_b32 %0, m0\n\ts_mov_b32 m0, %2\n\ts_nop 0\n\tglobal_load_lds_dwordx4 %1, off\n\ts_mov_b32 m0, %0" : "=&s"(keep) : "v"(gsrc), "s"(lds_dst) : "memory"); }
__device__ __forceinline__ float max3f(float a, float b, float c) { float r; asm("v_max3_f32 %0, %1, %2, %3" : "=v"(r) : "v"(a), "v"(b), "v"(c)); return r; }
__device__ __forceinline__ float max2f(float a, float b) { float r; asm("v_max_f32_e32 %0, %1, %2" : "=v"(r) : "v"(a), "v"(b)); return r; }
__device__ __forceinline__ float fadd_s(float a, float b) { float r; asm("v_add_f32_e32 %0, %1, %2" : "=v"(r) : "v"(a), "v"(b)); return r; }
__device__ __forceinline__ float fsub_s(float a, float b) { float r; asm("v_sub_f32_e32 %0, %1, %2" : "=v"(r) : "v"(a), "v"(b)); return r; }
typedef __bf16 bf16x2_t __attribute__((ext_vector_type(2)));
__device__ __forceinline__ unsigned cvtpk_s(float lo, float hi) { f32x2 v = {lo, hi}; bf16x2_t b = __builtin_convertvector(v, bf16x2_t); return __builtin_bit_cast(unsigned, b); }
#define WAIT_BAR(N) asm volatile("s_waitcnt vmcnt(" #N ") lgkmcnt(0)\n\ts_barrier" ::: "memory")
__device__ __forceinline__ void qkt(f32x16& p0, f32x16& p1, const char* Kslot, const bf16x8* qr, int r32, int hi) {
    const char* kb = Kslot + hi * 1024 + r32 * 16;
#pragma unroll
    for (int d0 = 0; d0 < 4; ++d0) {
        const bf16x8 b0 = *reinterpret_cast<const bf16x8*>(kb + d0 * 2048);
        const bf16x8 b1 = *reinterpret_cast<const bf16x8*>(kb + d0 * 2048 + 512);
        p0 = __builtin_amdgcn_mfma_f32_32x32x16_bf16(b0, qr[d0], p0, 0, 0, 0); p1 = __builtin_amdgcn_mfma_f32_32x32x16_bf16(b1, qr[d0], p1, 0, 0, 0); }
}
typedef LAS const char* lds_cptr;
typedef short v4i16_t __attribute__((ext_vector_type(4)));
__device__ __forceinline__ void kload8(bf16x8* kf, lds_cptr kp) {
    kf[0] = *(const LAS bf16x8*)(kp);        kf[1] = *(const LAS bf16x8*)(kp + 512);
    kf[2] = *(const LAS bf16x8*)(kp + 2048); kf[3] = *(const LAS bf16x8*)(kp + 2560);
    kf[4] = *(const LAS bf16x8*)(kp + 4096); kf[5] = *(const LAS bf16x8*)(kp + 4608);
    kf[6] = *(const LAS bf16x8*)(kp + 6144); kf[7] = *(const LAS bf16x8*)(kp + 6656);
}
__device__ __forceinline__ void kload2(bf16x8* kf, lds_cptr kp, int j) { kf[2 * j] = *(const LAS bf16x8*)(kp + j * 2048); kf[2 * j + 1] = *(const LAS bf16x8*)(kp + j * 2048 + 512); }
__device__ __forceinline__ s16x4 vtr(lds_cptr p) { return __builtin_bit_cast(s16x4, __builtin_amdgcn_ds_read_tr16_b64_v4i16((LAS v4i16_t*)p)); }
__device__ __forceinline__ float rowmax(const f32x16& p0, const f32x16& p1) {
    float a = max3f(p0[0], p0[1], p1[0]), b = max3f(p0[2], p0[3], p1[1]); a = max3f(a, p1[2], p1[3]);
#pragma unroll
    for (int r = 4; r < 16; r += 4) { a = max3f(a, p0[r], p0[r + 1]); b = max3f(b, p0[r + 2], p0[r + 3]); a = max3f(a, p1[r], p1[r + 1]); b = max3f(b, p1[r + 2], p1[r + 3]); }
    const float m = max2f(a, b);
    auto rr = __builtin_amdgcn_permlane32_swap(__float_as_uint(m), __float_as_uint(m), false, false);
    return max2f(__uint_as_float(rr[0]), __uint_as_float(rr[1]));
}
__device__ __forceinline__ void pv(f32x16* o, int vb, bf16x8 pa0, bf16x8 pa1, bf16x8 pa2, bf16x8 pa3) {
#pragma unroll
    for (int d0 = 0; d0 < 2; ++d0) { s16x4 lo[4], hi[4];
#pragma unroll
        for (int ks = 0; ks < 4; ++ks) {
            asm volatile("ds_read_b64_tr_b16 %0,%1 offset:%c2" : "=&v"(lo[ks]) : "v"(vb), "i"(d0 * 4096 + ks * 1024) : "memory");
            asm volatile("ds_read_b64_tr_b16 %0,%1 offset:%c2" : "=&v"(hi[ks]) : "v"(vb), "i"(d0 * 4096 + ks * 1024 + 512) : "memory"); }
        asm volatile("s_waitcnt lgkmcnt(0)" ::: "memory"); SBAR();
#define PK(k) (bf16x8){lo[k][0], lo[k][1], lo[k][2], lo[k][3], hi[k][0], hi[k][1], hi[k][2], hi[k][3]}
        o[d0] = __builtin_amdgcn_mfma_f32_32x32x16_bf16(pa0, PK(0), o[d0], 0, 0, 0);
        o[d0] = __builtin_amdgcn_mfma_f32_32x32x16_bf16(pa1, PK(1), o[d0], 0, 0, 0);
        o[d0] = __builtin_amdgcn_mfma_f32_32x32x16_bf16(pa2, PK(2), o[d0], 0, 0, 0);
        o[d0] = __builtin_amdgcn_mfma_f32_32x32x16_bf16(pa3, PK(3), o[d0], 0, 0, 0);
#undef PK
    }
}
__device__ __forceinline__ void mask_init(f32x16& p0, f32x16& p1, lds_cptr mp, lds_cptr tbl, int hi, float nm) {
    const u32x2 mw = *(const LAS u32x2*)mp;
    const unsigned lo = mw.x >> (4 * hi), hh = mw.y >> (4 * hi);
#pragma unroll
    for (int g = 0; g < 4; ++g) {
        const f32x4 b0 = *(const LAS f32x4*)(tbl + ((lo >> (8 * g)) & 15u) * 16);
        const f32x4 b1 = *(const LAS f32x4*)(tbl + ((hh >> (8 * g)) & 15u) * 16);
#pragma unroll
        for (int j = 0; j < 4; ++j) { p0[4 * g + j] = b0[j] + nm; p1[4 * g + j] = b1[j] + nm; }
    }
}
__device__ __forceinline__ void mask_load(f32x16& p0, f32x16& p1, u32x2 mw, lds_cptr tbl, int hi) {
    const unsigned lo = mw.x >> (4 * hi), hh = mw.y >> (4 * hi);
#pragma unroll
    for (int g = 0; g < 4; ++g) {
        const f32x4 b0 = *(const LAS f32x4*)(tbl + ((lo >> (8 * g)) & 15u) * 16);
        const f32x4 b1 = *(const LAS f32x4*)(tbl + ((hh >> (8 * g)) & 15u) * 16);
#pragma unroll
        for (int j = 0; j < 4; ++j) { p0[4 * g + j] = b0[j]; p1[4 * g + j] = b1[j]; }
    }
}
__device__ __forceinline__ void mask_add(f32x16& p0, f32x16& p1, float nm) {
#pragma unroll
    for (int r = 0; r < 16; ++r) { p0[r] += nm; p1[r] += nm; }
}
template <int THRL> __device__ __forceinline__ void attn_unit(int b, int h, int qb, const bf16* Q, const bf16* __restrict__ K, const bf16* __restrict__ V, bf16* O, const unsigned long long* BMp, char* shm) {
    const int tid = threadIdx.x, lane = tid & 63, r32 = lane & 31, hi = lane >> 5; const int wid = __builtin_amdgcn_readfirstlane(tid >> 6);
    const long rowbase = (long)b * SEQ; const int q0 = qb * QB;
    const bf16* Qw = Q + (rowbase + q0 + wid * QBLK) * DM + h * D;
    const bf16* Kh = K + rowbase * DM + h * D, *Vh = V + rowbase * DM + h * D;
    const unsigned lds0 = (unsigned)(uintptr_t)shm;
    float* wsf = (float*)(shm + LDS_WS) + wid * 64;
    const bf16* ksrc = Kh + (long)lane * DM + wid * 8;
    const bf16* vsrc = Vh + (long)(16 * (wid & 3) + (lane >> 2)) * DM + (wid >> 2) * 32 + (lane & 3) * 8;
    const unsigned kdst = lds0 + LDS_K + wid * 1024, vdst = lds0 + LDS_V + wid * 1024;
    const unsigned long long* msrc = BMp + ((size_t)(b * 128 + (lane >> 4)) * SEQ + q0 + wid * QBLK + 2 * (lane & 15));
    const unsigned mdst = lds0 + LDS_M + wid * 2048;
#define DMA_K(t, slot) glds16(ksrc + (long)(t) * KVBLK * DM, (unsigned)__builtin_amdgcn_readfirstlane(kdst + (slot)))
#define DMA_V(t, slot) glds16(vsrc + (long)(t) * KVBLK * DM, (unsigned)__builtin_amdgcn_readfirstlane(vdst + (slot)))
#define DMA_M(g) glds16(msrc + (size_t)(g) * 4 * SEQ, (unsigned)__builtin_amdgcn_readfirstlane(mdst + ((g) & 1) * 1024))
    const int vb0 = (int)(lds0 + LDS_V) + ((lane >> 4) & 1) * 32 + (lane & 3) * 8 + (4 * hi + ((lane & 15) >> 2)) * 64;
    const char* Kbase = shm + LDS_K; bf16x8 kf[8];
    const lds_cptr shm3 = (lds_cptr)shm; const lds_cptr kp0 = shm3 + LDS_K + hi * 1024 + r32 * 16; const lds_cptr vp0 = shm3 + LDS_V + ((lane >> 4) & 1) * 32 + (lane & 3) * 8 + (4 * hi + ((lane & 15) >> 2)) * 64;
    const lds_cptr mp0 = shm3 + LDS_M + wid * 2048 + r32 * 8; const lds_cptr tblp = shm3 + LDS_TBL;
    const int NT = (q0 + QB) / KVBLK;
    DMA_M(0); DMA_K(0, 0); DMA_V(0, 0); DMA_K(1, SLOTB);
    bf16x8 qr[4];
#pragma unroll
    for (int d0 = 0; d0 < 4; ++d0) qr[d0] = *reinterpret_cast<const bf16x8*>(&Qw[(long)r32 * DM + d0 * 16 + hi * 8]);
    float mhat = 0.f, l_reg = 0.f; f32x16 o[2]; o[0] = f32x16{}; o[1] = f32x16{};
#define MINIT(P0, P1, t) mask_init(P0, P1, mp0 + ((((t) >> 2) & 1) * 1024 + ((t) & 3) * 256), tblp, hi, -mhat)
#define MWORD(t) (*(const LAS u32x2*)(mp0 + ((((t) >> 2) & 1) * 1024 + ((t) & 3) * 256)))
    bool resc = false;
#define START(P0, P1) do { const float rm = rowmax(P0, P1); resc = false; \
    { const float dl = __builtin_fmaxf(rm, -64.f); mhat = fadd_s(mhat, dl); \
      _Pragma("unroll") for (int r = 0; r < 16; ++r) { P0[r] = fsub_s(P0[r], dl); P1[r] = fsub_s(P1[r], dl); } \
    } \
    _Pragma("unroll") for (int r = 0; r < 16; ++r) P0[r] = __builtin_amdgcn_exp2f(P0[r]); } while (0)
#define RESC() do { if (resc) { asm volatile("s_waitcnt lgkmcnt(0)" ::: "memory"); \
      _Pragma("unroll") for (int d_ = 0; d_ < 2; ++d_) _Pragma("unroll") for (int r = 0; r < 16; ++r) o[d_][r] *= wsf[crow(r, hi)]; } } while (0)
    f32x16 pA0, pA1, pB0, pB1;
    int sl_prev = 0, sl_cur = 0, sl_next = SLOTB;
#define ROT() do { sl_prev = sl_cur; sl_cur = sl_next; sl_next = (sl_next == (NSLOT - 1) * SLOTB) ? 0 : sl_next + SLOTB; } while (0)
    DMA_K(2, 2 * SLOTB);
    WAIT_BAR(3);
    MINIT(pA0, pA1, 0);
    qkt(pA0, pA1, Kbase, qr, r32, hi); asm volatile("s_nop 15\n\ts_nop 7" : "+v"(pA0), "+v"(pA1));
    START(pA0, pA1);
    _Pragma("unroll") for (int r = 0; r < 16; ++r) pA1[r] = __builtin_amdgcn_exp2f(pA1[r]);
    WAIT_BAR(0);
    DMA_K(3, 0); DMA_V(1, SLOTB);
    ROT();
    kload8(kf, kp0 + sl_cur);
    mask_load(pB0, pB1, MWORD(1), tblp, hi);
    WAIT_BAR(2);
    s16x4 vlo[8], vhi[8]; u32x4 pw0, pw1, pw2, pw3;
#define PKW(P, B) cvtpk_s(P[B], P[B + 1])
#define PAF(k) __builtin_bit_cast(bf16x8, pw##k)
#define VFR(i) (bf16x8){vlo[i][0], vlo[i][1], vlo[i][2], vlo[i][3], vhi[i][0], vhi[i][1], vhi[i][2], vhi[i][3]}
#define PIN(x) asm volatile("" : "+v"(x))
#define MX3(a, b, c) __builtin_fmaxf(__builtin_fmaxf((a), (b)), (c))
#define GAPA(MF, A0, A1, A2, A3, W0, W1, PW) do { MF; sacc += A0; sacc += A1; sacc += A2; sacc += A3; PIN(sacc); W0; W1; PIN(PW); SBAR(); } while (0)
#define EX(v) __builtin_amdgcn_exp2f(v)
#define GAPB(MF, X, B) do { MF; X[B] = EX(X[B]); X[B + 1] = EX(X[B + 1]); X[B + 2] = EX(X[B + 2]); X[B + 3] = EX(X[B + 3]); PIN(X); SBAR(); } while (0)
#define VRD(i) do { vlo[i] = vtr(vp_ + (((i) >> 2) * 4096 + ((i) & 3) * 1024)); vhi[i] = vtr(vp_ + (((i) >> 2) * 4096 + ((i) & 3) * 1024 + 512)); } while (0)
#define KRD(G, j) do { if (G) { kload2(kf, kp0 + sl_next, j); SBAR(); } } while (0)
#define STEP(C0, C1, P0, P1, t, GK, GV, GL) do { SBAR(); \
    u32x2 mwn_ = {0u, 0u}; if ((t) + 1 < NT) mwn_ = MWORD((t) + 1); \
    mask_add(C0, C1, -mhat); SBAR(); \
    const lds_cptr vp_ = vp0 + sl_prev; \
    VRD(0); SBAR(); float sacc = (P0[0] + P0[1]); \
    GAPA(C0 = __builtin_amdgcn_mfma_f32_32x32x16_bf16(kf[0], qr[0], C0, 0, 0, 0), P0[2], P0[3], P0[4], P0[5],     pw0[0] = PKW(P0, 0), pw0[1] = PKW(P0, 2), pw0); \
    VRD(4); SBAR(); GAPA(C1 = __builtin_amdgcn_mfma_f32_32x32x16_bf16(kf[1], qr[0], C1, 0, 0, 0), P0[6], P0[7], P0[8], P0[9],     pw0[2] = PKW(P0, 4), pw0[3] = PKW(P0, 6), pw0); \
    VRD(1); SBAR(); GAPA(C0 = __builtin_amdgcn_mfma_f32_32x32x16_bf16(kf[2], qr[1], C0, 0, 0, 0),   P0[10], P0[11], P0[12], P0[13], pw1[0] = PKW(P0, 8), pw1[1] = PKW(P0, 10), pw1); \
    VRD(5); SBAR(); GAPA(C1 = __builtin_amdgcn_mfma_f32_32x32x16_bf16(kf[3], qr[1], C1, 0, 0, 0),   P0[14], P0[15], P1[0], P1[1],   pw1[2] = PKW(P0, 12), pw1[3] = PKW(P0, 14), pw1); \
    VRD(2); SBAR(); GAPA(C0 = __builtin_amdgcn_mfma_f32_32x32x16_bf16(kf[4], qr[2], C0, 0, 0, 0),   P1[2], P1[3], P1[4], P1[5],     pw2[0] = PKW(P1, 0), pw2[1] = PKW(P1, 2), pw2); \
    VRD(6); SBAR(); GAPA(C1 = __builtin_amdgcn_mfma_f32_32x32x16_bf16(kf[5], qr[2], C1, 0, 0, 0),   P1[6], P1[7], P1[8], P1[9],     pw2[2] = PKW(P1, 4), pw2[3] = PKW(P1, 6), pw2); \
    VRD(3); SBAR(); GAPA(C0 = __builtin_amdgcn_mfma_f32_32x32x16_bf16(kf[6], qr[3], C0, 0, 0, 0),   P1[10], P1[11], P1[12], P1[13], pw3[0] = PKW(P1, 8), pw3[1] = PKW(P1, 10), pw3); \
    VRD(7); SBAR(); GAPA(C1 = __builtin_amdgcn_mfma_f32_32x32x16_bf16(kf[7], qr[3], C1, 0, 0, 0),   P1[14], P1[15], 0.f, 0.f,       pw3[2] = PKW(P1, 12), pw3[3] = PKW(P1, 14), pw3); \
    l_reg += sacc; \
    if ((((t) & 3) == 1) && ((t) + 3 < NT)) { DMA_M(((t) >> 2) + 1); } \
    if (GK) { DMA_K((t) + 3, sl_cur); } if (GV) { DMA_V((t) + 1, sl_next); } \
    { float a = MX3(C0[0], C0[1], C1[0]), b = MX3(C0[2], C0[3], C1[1]); a = MX3(a, C1[2], C1[3]); \
      _Pragma("unroll") for (int r = 4; r < 16; r += 4) { a = MX3(a, C0[r], C0[r + 1]); b = MX3(b, C0[r + 2], C0[r + 3]); a = MX3(a, C1[r], C1[r + 1]); b = MX3(b, C1[r + 2], C1[r + 3]); } \
      float rm = __builtin_fmaxf(a, b); { auto rr = __builtin_amdgcn_permlane32_swap(__float_as_uint(rm), __float_as_uint(rm), false, false); rm = __builtin_fmaxf(__uint_as_float(rr[0]), __uint_as_float(rr[1])); } \
      resc = false; \
      if (__builtin_expect(__any(rm > (float)THRL), 0)) { const float dl = __builtin_fmaxf(rm, 0.f); mhat += dl; \
        _Pragma("unroll") for (int r = 0; r < 16; ++r) { C0[r] -= dl; C1[r] -= dl; } \
        const float f = __builtin_amdgcn_exp2f(-dl); l_reg *= f; if (hi == 0) wsf[r32] = f; resc = true; } } \
    if ((t) + 1 < NT) mask_load(P0, P1, mwn_, tblp, hi); \
    SBAR(); \
    GAPB(o[0] = __builtin_amdgcn_mfma_f32_32x32x16_bf16(PAF(0), VFR(0), o[0], 0, 0, 0), C0, 0); \
    GAPB(o[1] = __builtin_amdgcn_mfma_f32_32x32x16_bf16(PAF(0), VFR(4), o[1], 0, 0, 0), C0, 4); \
    KRD(GL, 0); GAPB(o[0] = __builtin_amdgcn_mfma_f32_32x32x16_bf16(PAF(1), VFR(1), o[0], 0, 0, 0), C0, 8); \
    KRD(GL, 1); GAPB(o[1] = __builtin_amdgcn_mfma_f32_32x32x16_bf16(PAF(1), VFR(5), o[1], 0, 0, 0), C0, 12); \
    KRD(GL, 2); GAPB(o[0] = __builtin_amdgcn_mfma_f32_32x32x16_bf16(PAF(2), VFR(2), o[0], 0, 0, 0), C1, 0); \
    KRD(GL, 3); GAPB(o[1] = __builtin_amdgcn_mfma_f32_32x32x16_bf16(PAF(2), VFR(6), o[1], 0, 0, 0), C1, 4); \
    GAPB(o[0] = __builtin_amdgcn_mfma_f32_32x32x16_bf16(PAF(3), VFR(3), o[0], 0, 0, 0), C1, 8); \
    GAPB(o[1] = __builtin_amdgcn_mfma_f32_32x32x16_bf16(PAF(3), VFR(7), o[1], 0, 0, 0), C1, 12); \
    } while (0)
    int t = 1;
    for (; t + 5 < NT; t += 2) {
        STEP(pB0, pB1, pA0, pA1, t, true, true, true);     WAIT_BAR(2); RESC(); ROT();
        STEP(pA0, pA1, pB0, pB1, t + 1, true, true, true);   WAIT_BAR(2); RESC(); ROT();
    }
#define ENDW(tt) do { if ((tt) + 3 < NT) { WAIT_BAR(2); } else if ((tt) + 2 < NT) { WAIT_BAR(1); } else { WAIT_BAR(0); } } while (0)
    for (; t + 1 < NT; t += 2) {
        STEP(pB0, pB1, pA0, pA1, t, (t + 3 < NT), (t + 1 < NT), (t + 1 < NT));       ENDW(t);   RESC(); ROT();
        STEP(pA0, pA1, pB0, pB1, t + 1, (t + 4 < NT), (t + 2 < NT), (t + 2 < NT));     ENDW(t + 1); RESC(); ROT();
    }
    STEP(pB0, pB1, pA0, pA1, NT - 1, false, false, false); RESC();
    { float sacc = pB0[0] + pB0[1]; _Pragma("unroll") for (int r = 2; r < 16; ++r) sacc += pB0[r]; _Pragma("unroll") for (int r = 0; r < 16; ++r) sacc += pB1[r]; l_reg += sacc;
      pw0 = (u32x4){PKW(pB0, 0), PKW(pB0, 2), PKW(pB0, 4), PKW(pB0, 6)}; pw1 = (u32x4){PKW(pB0, 8), PKW(pB0, 10), PKW(pB0, 12), PKW(pB0, 14)}; pw2 = (u32x4){PKW(pB1, 0), PKW(pB1, 2), PKW(pB1, 4), PKW(pB1, 6)}; pw3 = (u32x4){PKW(pB1, 8), PKW(pB1, 10), PKW(pB1, 12), PKW(pB1, 14)};
      SBAR(); pv(o, vb0 + sl_cur, PAF(0), PAF(1), PAF(2), PAF(3)); }
#undef PKW
#undef PAF
#undef VFR
#undef PIN
#undef MX3
#undef GAPA
#undef GAPB
#undef EX
#undef VRD
#undef KRD
#undef STEP
#undef ENDW
    { auto rr = __builtin_amdgcn_permlane32_swap(__float_as_uint(l_reg), __float_as_uint(l_reg), false, false); l_reg = __uint_as_float(rr[0]) + __uint_as_float(rr[1]); }
    if (hi == 0) wsf[32 + r32] = l_reg; asm volatile("s_waitcnt lgkmcnt(0)" ::: "memory");
    float rli[16];
#pragma unroll
    for (int r = 0; r < 16; ++r) rli[r] = __builtin_amdgcn_rcpf(wsf[32 + crow(r, hi)]);
    bf16* Ow = O + (rowbase + q0 + wid * QBLK) * DM + h * D;
    { bf16* stg = (bf16*)(shm + LDS_OST) + wid * 2048;
#pragma unroll
      for (int r = 0; r < 16; ++r) { const int orow = crow(r, hi);
#pragma unroll
          for (int d0 = 0; d0 < 2; ++d0) stg[orow * 64 + d0 * 32 + r32] = __float2bfloat16(o[d0][r] * rli[r]); }
      asm volatile("s_waitcnt lgkmcnt(0)" ::: "memory");
#pragma unroll
      for (int i = 0; i < 4; ++i) { const int row = i * 8 + (lane >> 3), ch = lane & 7; const u32x4 v = *(const u32x4*)(stg + row * 64 + ch * 8); *(u32x4*)(Ow + (long)row * DM + ch * 8) = v; } }
    asm volatile("s_waitcnt lgkmcnt(0)\n\ts_barrier" ::: "memory");
#undef DMA_K
#undef DMA_V
#undef DMA_M
#undef MINIT
#undef MWORD
#undef START
#undef RESC
#undef ROT
}
#undef SBAR
#undef WAIT_BAR
}

constexpr int RING_OFF = 0, RING_BYTES = 131072;
constexpr int LDSCTL_OFF = 139264, MISC_OFF = LDSCTL_OFF + 320;
constexpr int LDS_BYTES = 147456;
typedef GAS unsigned gu32;

#define XB_TMO      128
#define XB_XCNT(j)  (256  + 64 * (j))
#define XB_XSUB(j)  (1280 + 64 * (j))
#define XB_XGEN(j)  (2304 + 64 * (j))
#define XB_TOP      3328
#define XB_TOPGEN   3392
#define XCD_BAR_WORDS 3456
#define XB_SPIN_CAP (1u << 22)
__device__ __forceinline__ unsigned xb_ld(unsigned* p)              { return __hip_atomic_load(p, __ATOMIC_RELAXED, __HIP_MEMORY_SCOPE_AGENT); }
__device__ __forceinline__ unsigned xb_add(unsigned* p, unsigned v) { return __hip_atomic_fetch_add(p, v, __ATOMIC_RELAXED, __HIP_MEMORY_SCOPE_AGENT); }
__device__ __forceinline__ unsigned xb_xcc_id() { return (unsigned)__builtin_amdgcn_s_getreg((3 << 11) | 20) & 0xFu; }
#define XB_SPIN(cond, bar) do { unsigned _sp = 0; while (cond) { __builtin_amdgcn_s_sleep(1); \
    if ((++_sp & 255u) == 0u) { if (xb_ld(&(bar)[XB_TMO])) break; if (_sp > XB_SPIN_CAP) { atomicAdd(&(bar)[XB_TMO], 1u); break; } } } } while (0)
struct XcdBarrier { unsigned* bar; unsigned x; volatile LAS unsigned* st; };
__device__ __forceinline__ XcdBarrier xcd_barrier_post(unsigned* bar, volatile LAS unsigned* st) {
    XcdBarrier b; b.bar = bar; b.x = xb_xcc_id(); b.st = st;
    if (threadIdx.x == 0) (void)xb_add(&bar[XB_XCNT(b.x)], 1u);
    return b;
}
__device__ __forceinline__ void xcd_barrier_complete(unsigned* bar, unsigned x, unsigned& nloc, unsigned& nx) {
    const unsigned G = gridDim.x * gridDim.y * gridDim.z;
    unsigned sum, cnt, mine, sp = 0u;
    for (;;) {
        sum = 0u; cnt = 0u; mine = 0u;
#pragma unroll
        for (unsigned j = 0; j < 16; ++j) { const unsigned c = xb_ld(&bar[XB_XCNT(j)]); sum += c; cnt += (c > 0u) ? 1u : 0u; mine = (j == x) ? c : mine; }
        if (sum == G) break;
        __builtin_amdgcn_s_sleep(1);
        if ((++sp & 255u) == 0u) { if (xb_ld(&bar[XB_TMO])) break; if (sp > XB_SPIN_CAP) { atomicAdd(&bar[XB_TMO], 1u); break; } }
    }
    nloc = mine > 0u ? mine : 1u; nx = cnt > 0u ? cnt : 1u;
}
__device__ __forceinline__ void xcd_barrier(const XcdBarrier& b) {
    asm volatile("s_waitcnt vmcnt(0)" ::: "memory");
    __syncthreads();
    if (threadIdx.x == 0) {
        unsigned* bar = b.bar;
        __builtin_amdgcn_s_waitcnt(0);
        unsigned nloc = b.st[0], nx = b.st[1];
        if (nloc == 0u) { xcd_barrier_complete(bar, b.x, nloc, nx); b.st[0] = nloc; b.st[1] = nx; }
        const unsigned old = xb_add(&bar[XB_XSUB(b.x)], 1u);
        const unsigned gen = old / nloc;
        if (old + 1u == (gen + 1u) * nloc) {
            __builtin_amdgcn_fence(__ATOMIC_RELEASE, "agent");
            asm volatile("s_waitcnt vmcnt(0)" ::: "memory");
            const unsigned og = xb_add(&bar[XB_TOP], 1u);
            const unsigned tg = og / nx;
            if (og + 1u == (tg + 1u) * nx) xb_add(&bar[XB_TOPGEN], 1u);
            else XB_SPIN(xb_ld(&bar[XB_TOPGEN]) == tg, bar);
            __builtin_amdgcn_fence(__ATOMIC_ACQUIRE, "agent");
            xb_add(&bar[XB_XGEN(b.x)], 1u);
            asm volatile("s_waitcnt vmcnt(0)" ::: "memory");
        } else {
            XB_SPIN(xb_ld(&bar[XB_XGEN(b.x)]) == gen, bar);
            __builtin_amdgcn_fence(__ATOMIC_ACQUIRE, "agent");
            asm volatile("s_waitcnt vmcnt(0)" ::: "memory");
        }
    }
    __syncthreads();
}

struct Frame {
    LAS unsigned char* lds; unsigned char* ldsg;
    int tid, lane, wave, vcu, G;
    const float* in[13]; float* out; unsigned char* ws;
};

__device__ __forceinline__ int perm_part(int c) {
    const int hp = c & 63;
    if (hp >= 16) return c;
    const int q = hp >> 3, r = hp & 7;
    return (c & ~63) + ((r < 4) ? (4 * q + r) : (8 + 4 * q + (r - 4)));
}
__device__ __forceinline__ int win_src_col(int p) {
    const int tile = p >> 8, c = p & 255;
    if (tile <= 1) { const int head = (c & 127) >> 5, d = c & 31; return tile * 256 + head * 64 + ((c >= 128) ? 32 : 0) + d; }
    if (tile <= 5) return 512 + (tile - 2) * 256 + c;
    if (tile <= 9) return 1536 + (tile - 6) * 256 + perm_part(c);
    if (tile <= 11) return 2560 + (tile - 10) * 256 + c;
    if (tile == 12) return 3072 + perm_part(c);
    if (tile == 13) { if (c < 64) return 3328 + perm_part(c); if (c < 68) return 3392 + (c - 64); return -1; }
    return 3396 + (tile - 14) * 256 + c;
}
template <bool MAP> __device__ __forceinline__ void p0_transpose_item(const float* W, int K, int N, u16* WT, LAS float* scr, int item, int nblk, int lane, const float* gk = nullptr) {
    const int kb = item / nblk, nb = item % nblk, k0 = 64 * kb, n0 = 32 * nb;
    const int sc = MAP ? win_src_col(n0 + (lane & 31)) : (n0 + (lane & 31));
#pragma unroll
    for (int i = 0; i < 32; ++i) { const int kk = 2 * i + (lane >> 5); scr[kk * 33 + (lane & 31)] = (sc >= 0) ? W[(size_t)(k0 + kk) * N + sc] * (MAP ? gk[k0 + kk] : 1.0f) : 0.f; }
    LDS_WAIT(); asm volatile("" ::: "memory");
    const int c = lane & 7;
#pragma unroll
    for (int j = 0; j < 4; ++j) { const int n = (lane >> 3) + 8 * j; const LAS float* s = scr + (8 * c) * 33 + n;
        u32x4 o; o.x = f2bf(s[0 * 33]) | (f2bf(s[1 * 33]) << 16); o.y = f2bf(s[2 * 33]) | (f2bf(s[3 * 33]) << 16); o.z = f2bf(s[4 * 33]) | (f2bf(s[5 * 33]) << 16); o.w = f2bf(s[6 * 33]) | (f2bf(s[7 * 33]) << 16);
        *(u32x4*)(WT + (size_t)(n0 + n) * K + k0 + 8 * c) = o; }
    LDS_WAIT(); asm volatile("" ::: "memory");
}
__device__ __forceinline__ void p0_prologue(Frame& F) {
    const float* x = F.in[0]; const float* attn_norm = F.in[1]; const float* w_in = F.in[2];
    const float* w_ret_o = F.in[4]; const float* w_dsa_o = F.in[5]; const float* w_out = F.in[6]; const float* ffn_norm = F.in[7];
    const float* peer_wq = F.in[8]; const float* subkeys = F.in[9]; const float* peer_u = F.in[10]; const float* peer_v = F.in[11];
    unsigned char* ws = F.ws;
    {
        u16* WSC = (u16*)(ws + WS_WSC);
        const int lane = F.lane, l32 = lane & 31, hi = lane >> 5, ri = F.wave & 1, ci = F.wave >> 1;
        for (int item = F.vcu; item < 256; item += F.G) {
            const int blk = item >> 4, i0 = (item & 15) * 64 + 32 * ri, k0 = 32 * ci;
            const float* ap = peer_wq + (size_t)(i0 + l32) * 2048 + blk * 128 + 8 * hi;
            const float* bp = subkeys + (size_t)(blk * 128 + k0 + l32) * 128 + 8 * hi;
            f32x4 av[8][2], bv[8][2];
#pragma unroll
            for (int kk = 0; kk < 8; ++kk) { av[kk][0] = *(const f32x4*)(ap + 16 * kk); av[kk][1] = *(const f32x4*)(ap + 16 * kk + 4); bv[kk][0] = *(const f32x4*)(bp + 16 * kk); bv[kk][1] = *(const f32x4*)(bp + 16 * kk + 4); }
            f32x16 acc = {};
#pragma unroll
            for (int kk = 0; kk < 8; ++kk) {
                const u32x4 aw = {cvt_pk_bf16(av[kk][0][0], av[kk][0][1]), cvt_pk_bf16(av[kk][0][2], av[kk][0][3]), cvt_pk_bf16(av[kk][1][0], av[kk][1][1]), cvt_pk_bf16(av[kk][1][2], av[kk][1][3])};
                const u32x4 bw = {cvt_pk_bf16(bv[kk][0][0], bv[kk][0][1]), cvt_pk_bf16(bv[kk][0][2], bv[kk][0][3]), cvt_pk_bf16(bv[kk][1][0], bv[kk][1][1]), cvt_pk_bf16(bv[kk][1][2], bv[kk][1][3])};
                acc = __builtin_amdgcn_mfma_f32_32x32x16_bf16(__builtin_bit_cast(bf16x8, aw), __builtin_bit_cast(bf16x8, bw), acc, 0, 0, 0);
            }
#pragma unroll
            for (int q = 0; q < 4; ++q) { const int ib = i0 + 8 * q + 4 * hi; const f32x4 gn = *(const f32x4*)(ffn_norm + ib);
                u32x2 w; w.x = cvt_pk_bf16(acc[4 * q] * gn[0], acc[4 * q + 1] * gn[1]); w.y = cvt_pk_bf16(acc[4 * q + 2] * gn[2], acc[4 * q + 3] * gn[3]);
                *(u32x2*)(WSC + (size_t)(blk * 128 + k0 + l32) * 1024 + ib) = w; }
        }
    }
    LAS float* scr = (LAS float*)(F.lds + F.wave * 16384);
    const int gw = F.vcu * NWAVES + F.wave, NGW = F.G * NWAVES;
    constexpr int I_IN = 16 * (N1PAD / 32), I_RO = 8 * 32, I_DO = 8 * 32, I_OUT = 16 * 32;
    constexpr int NITEMS = I_IN + I_RO + I_DO + I_OUT;
    for (int it = gw; it < NITEMS; it += NGW) {
        int r = it;
        if (r < I_IN) { p0_transpose_item<true>(w_in, 1024, D_IN, (u16*)(ws + WS_WIN), scr, r, N1PAD / 32, F.lane, attn_norm); continue; } r -= I_IN;
        if (r < I_RO) { p0_transpose_item<false>(w_ret_o, 512, 1024, (u16*)(ws + WS_WRO), scr, r, 32, F.lane); continue; } r -= I_RO;
        if (r < I_DO) { p0_transpose_item<false>(w_dsa_o, 512, 1024, (u16*)(ws + WS_WDO), scr, r, 32, F.lane); continue; } r -= I_DO;
        p0_transpose_item<false>(w_out, 1024, 1024, (u16*)(ws + WS_WOUT), scr, r, 32, F.lane);
    }
    {
        u16* H = (u16*)(ws + WS_XB); float* RS = (float*)(ws + WS_RSTD);
        for (int m0 = gw; m0 < NTOK; m0 += 2 * NGW) {
            const int m1 = (m0 + NGW < NTOK) ? m0 + NGW : m0;
            const f32x4* xr0 = (const f32x4*)(x + (size_t)m0 * DMODEL) + F.lane; const f32x4* xr1 = (const f32x4*)(x + (size_t)m1 * DMODEL) + F.lane;
            f32x4 v0[4], v1[4]; float s0 = 0.f, s1 = 0.f;
#pragma unroll
            for (int j = 0; j < 4; ++j) { v0[j] = xr0[64 * j]; v1[j] = xr1[64 * j]; }
#pragma unroll
            for (int j = 0; j < 4; ++j) { s0 += (v0[j].x * v0[j].x + v0[j].y * v0[j].y) + (v0[j].z * v0[j].z + v0[j].w * v0[j].w); s1 += (v1[j].x * v1[j].x + v1[j].y * v1[j].y) + (v1[j].z * v1[j].z + v1[j].w * v1[j].w); }
            const float rstd0 = 1.0f / sqrtf(wave_sum(s0) * (1.f / DMODEL) + EPS), rstd1 = 1.0f / sqrtf(wave_sum(s1) * (1.f / DMODEL) + EPS);
            u32x2* o0 = (u32x2*)(H + (size_t)m0 * DMODEL) + F.lane; u32x2* o1 = (u32x2*)(H + (size_t)m1 * DMODEL) + F.lane;
#pragma unroll
            for (int j = 0; j < 4; ++j) { u32x2 w; w.x = cvt_pk_bf16(v0[j].x, v0[j].y); w.y = cvt_pk_bf16(v0[j].z, v0[j].w); o0[64 * j] = w;
                u32x2 w2; w2.x = cvt_pk_bf16(v1[j].x, v1[j].y); w2.y = cvt_pk_bf16(v1[j].z, v1[j].w); o1[64 * j] = w2; }
            if (F.lane == 0) { RS[m0] = rstd0; RS[m1] = rstd1; }
        }
    }
    {
        const int gwv = F.vcu * NWAVES + F.wave, NWV = F.G * NWAVES;
        unsigned* KUV = (unsigned*)(ws + WS_KUV);
        for (int r = gwv; r < 16384; r += NWV) {
            f32x4 a[2][4];
#pragma unroll
            for (int u = 0; u < 2; ++u) { const f32x4* src = (const f32x4*)((u ? peer_v : peer_u) + (size_t)r * 1024 + 16 * F.lane);
#pragma unroll
                for (int q = 0; q < 4; ++q) a[u][q] = src[q]; }
            unsigned kk = 0;
#pragma unroll
            for (int u = 0; u < 2; ++u) {
                float m = 0.f;
#pragma unroll
                for (int q = 0; q < 4; ++q) m = fmaxf(fmaxf(m, fmaxf(fabsf(a[u][q][0]), fabsf(a[u][q][1]))), fmaxf(fabsf(a[u][q][2]), fabsf(a[u][q][3])));
                m = wave_max(m);
                const int eb = (int)((__float_as_uint(m) >> 23) & 0xffu);
                int k = eb ? 129 - eb : 0; k = k < -64 ? -64 : (k > 63 ? 63 : k);
                const float sc = __uint_as_float((unsigned)(127 + k) << 23);
                unsigned c[16];
#pragma unroll
                for (int q = 0; q < 4; ++q)
#pragma unroll
                    for (int j = 0; j < 4; ++j) c[4 * q + j] = fp6_code(a[u][q][j] * sc);
                U3 w;
                w.x = c[0] | (c[1] << 6) | (c[2] << 12) | (c[3] << 18) | (c[4] << 24) | (c[5] << 30);
                w.y = (c[5] >> 2) | (c[6] << 4) | (c[7] << 10) | (c[8] << 16) | (c[9] << 22) | (c[10] << 28);
                w.z = (c[10] >> 4) | (c[11] << 2) | (c[12] << 8) | (c[13] << 14) | (c[14] << 20) | (c[15] << 26);
                *(U3*)(ws + (u ? WS_V : WS_U) + (size_t)r * 768 + 12 * F.lane) = w;
                kk |= (unsigned)(k + 64) << (8 * u);
            }
            if (F.lane == 0) KUV[r] = kk;
        }
        const size_t gt = (size_t)F.vcu * 512 + F.tid, NT_ = (size_t)F.G * 512;
        f32x2* ta = (f32x2*)(ws + WS_TABA); f32x2* tb = (f32x2*)(ws + WS_TABB);
        for (size_t i = gt; i < (size_t)SEQ * 40; i += NT_) {
            const int pos = (int)(i / 40), k = (int)(i % 40);
            const float inv = (k < 32) ? exp2f(-(float)k * (13.287712379549449f / 32.0f)) : exp2f(-(float)(k - 32) * (18.931568569324174f / 8.0f));
            const float ang = (float)pos * inv;
            float sn_, cs_; sincosf(ang, &sn_, &cs_);
            const f32x2 cs = {cs_, sn_};
            if (k < 32) ta[pos * 32 + k] = cs; else tb[pos * 8 + (k - 32)] = cs;
        }
    }
}

__device__ __forceinline__ float ret_logg(int h) { return logf(1.0f - exp2f(-5.0f - (float)h)); }
constexpr int RS_K = 72, RS_V = 136;
__device__ __forceinline__ bf16x8 gather8(const LAS u16* p, int stride) {
    bf16x8 v;
#pragma unroll
    for (int i = 0; i < 8; ++i) v[i] = (short)p[i * stride];
    return v;
}
struct KvIn { u32x4 k, v[2]; };
__device__ __forceinline__ void ret_kv_load(Frame& F, int item, KvIn& I) {
    const int h = item & 3, bn = item >> 2;
    const u16* RKp = (const u16*)(F.ws + WS_RK) + (size_t)bn * 64 * 256 + h * 64;
    const u16* RVp = (const u16*)(F.ws + WS_RV) + (size_t)bn * 64 * 512 + h * 128;
    { const int j = F.tid >> 3, c = (F.tid & 7) * 8; I.k = *(const u32x4*)(RKp + (size_t)j * 256 + c); }
#pragma unroll
    for (int i = 0; i < 2; ++i) { const int e = F.tid + 512 * i; const int j = e >> 4, c = (e & 15) * 8; I.v[i] = *(const u32x4*)(RVp + (size_t)j * 512 + c); }
}
__device__ __forceinline__ void ret_kv_item(Frame& F, int item, KvIn& I, int nxt) {
    const int h = item & 3;
    float* kvp = (float*)((unsigned char*)F.out + OUT_KV) + (size_t)item * 8192;
    LAS u16* Ks = (LAS u16*)F.lds; LAS u16* Vs = (LAS u16*)(F.lds + 64 * RS_K * 2);
    const float lg = ret_logg(h);
    { const int j = F.tid >> 3, c = (F.tid & 7) * 8;
      const u32x4 kv4 = I.k; const float dec = __expf(lg * (float)(63 - j));
      const unsigned w[4] = {kv4.x, kv4.y, kv4.z, kv4.w}; u32x4 o;
      unsigned r[4];
#pragma unroll
      for (int q = 0; q < 4; ++q) r[q] = cvt_pk_bf16(bf2f(w[q] & 0xffffu) * dec, bf2f(w[q] >> 16) * dec);
      o.x = r[0]; o.y = r[1]; o.z = r[2]; o.w = r[3];
      *(LAS u32x4*)(Ks + j * RS_K + c) = o; }
#pragma unroll
    for (int i = 0; i < 2; ++i) { const int e = F.tid + 512 * i; const int j = e >> 4, c = (e & 15) * 8;
      *(LAS u32x4*)(Vs + j * RS_V + c) = I.v[i]; }
    LDS_WAIT(); __builtin_amdgcn_s_barrier();
    if (nxt >= 0) ret_kv_load(F, nxt, I);
    const int td = F.wave >> 2, te = F.wave & 3, r32 = F.lane & 31, hi = F.lane >> 5;
    f32x16 acc = {};
#pragma unroll
    for (int kk = 0; kk < 4; ++kk) {
        const bf16x8 a = gather8(Ks + (16 * kk + 8 * hi) * RS_K + 32 * td + r32, RS_K);
        const bf16x8 bb = gather8(Vs + (16 * kk + 8 * hi) * RS_V + 32 * te + r32, RS_V);
        acc = __builtin_amdgcn_mfma_f32_32x32x16_bf16(a, bb, acc, 0, 0, 0);
    }
#pragma unroll
    for (int r = 0; r < 16; ++r) { const int d = 32 * td + (r & 3) + 8 * (r >> 2) + 4 * hi; kvp[d * 128 + 32 * te + r32] = acc[r]; }
    LDS_WAIT(); __builtin_amdgcn_s_barrier();
}
__device__ __forceinline__ void ret_scan(Frame& F) {
    float* kv = (float*)((unsigned char*)F.out + OUT_KV);
    for (int idx = F.vcu * 512 + F.tid; idx < 16 * 8192; idx += F.G * 512) {
        const int bh = idx >> 13, de = idx & 8191, b = bh >> 2, h = bh & 3;
        const float cd = __expf(ret_logg(h) * 64.0f);
        float* p = kv + ((size_t)(b * 128) * 4 + h) * 8192 + de;
        float s = 0.f;
        float ta[32], tb[32];
#define SCAN_LD(buf, n0) _Pragma("unroll") for (int i = 0; i < 32; ++i) buf[i] = p[(size_t)((n0) + i) * 4 * 8192]
#define SCAN_RUN(buf, n0) _Pragma("unroll") for (int i = 0; i < 32; ++i) { p[(size_t)((n0) + i) * 4 * 8192] = s; s = cd * s + buf[i]; }
        SCAN_LD(ta, 0); SCAN_LD(tb, 32);
        SCAN_RUN(ta, 0); SCAN_LD(ta, 64);
        SCAN_RUN(tb, 32); SCAN_LD(tb, 96);
        SCAN_RUN(ta, 64); SCAN_RUN(tb, 96);
#undef SCAN_LD
#undef SCAN_RUN
    }
}
struct OutIn { u32x4 q, k, v[2]; f32x4 p[2][2]; };
__device__ __forceinline__ void ret_out_load(Frame& F, int item, OutIn& I) {
    const int h = item & 3, bn = item >> 2; const size_t tok0 = (size_t)bn * 64;
    const u16* RQp = (const u16*)(F.ws + WS_RQ) + tok0 * 256 + h * 64; const u16* RKp = (const u16*)(F.ws + WS_RK) + tok0 * 256 + h * 64;
    const u16* RVp = (const u16*)(F.ws + WS_RV) + tok0 * 512 + h * 128;
    const float* kvp = (const float*)((unsigned char*)F.out + OUT_KV) + (size_t)item * 8192;
    { const int j = F.tid >> 3, c = (F.tid & 7) * 8; I.q = *(const u32x4*)(RQp + (size_t)j * 256 + c); I.k = *(const u32x4*)(RKp + (size_t)j * 256 + c); }
#pragma unroll
    for (int i = 0; i < 2; ++i) { const int e = F.tid + 512 * i; const int j = e >> 4, c = (e & 15) * 8;
        I.v[i] = *(const u32x4*)(RVp + (size_t)j * 512 + c); I.p[i][0] = *(const f32x4*)(kvp + j * 128 + c); I.p[i][1] = *(const f32x4*)(kvp + j * 128 + c + 4); }
}
__device__ __forceinline__ void ret_out_item(Frame& F, int item, OutIn& I, int nxt) {
    const int h = item & 3, bn = item >> 2;
    const size_t tok0 = (size_t)bn * 64;
    const u16* RGp = (const u16*)(F.ws + WS_RG) + tok0 * 512 + h * 128;
    const float* gn = F.in[3] + h * 128;
    u16* YR = (u16*)(F.ws + WS_YRET) + tok0 * 512 + h * 128;
    LAS u16* Qs = (LAS u16*)F.lds; LAS u16* Ks = Qs + 64 * RS_K; LAS u16* Vs = Ks + 64 * RS_K; LAS u16* Ps = Vs + 64 * RS_V;
    LAS u16* Sw = Ps + 64 * RS_V + F.wave * (32 * RS_K); LAS float* Ys = (LAS float*)(Ps + 64 * RS_V + 8 * 32 * RS_K);
    const float lg = ret_logg(h);
    { const int j = F.tid >> 3, c = (F.tid & 7) * 8;
      *(LAS u32x4*)(Qs + j * RS_K + c) = I.q;
      *(LAS u32x4*)(Ks + j * RS_K + c) = I.k; }
#pragma unroll
    for (int i = 0; i < 2; ++i) { const int e = F.tid + 512 * i; const int j = e >> 4, c = (e & 15) * 8;
      *(LAS u32x4*)(Vs + j * RS_V + c) = I.v[i];
      const f32x4 p0 = I.p[i][0], p1 = I.p[i][1];
      u32x4 w; w.x = cvt_pk_bf16(p0[0], p0[1]); w.y = cvt_pk_bf16(p0[2], p0[3]); w.z = cvt_pk_bf16(p1[0], p1[1]); w.w = cvt_pk_bf16(p1[2], p1[3]);
      *(LAS u32x4*)(Ps + j * RS_V + c) = w; }
    LDS_WAIT(); __builtin_amdgcn_s_barrier();
    if (nxt >= 0) ret_out_load(F, nxt, I);
    const int ti = F.wave >> 2, te = F.wave & 3, r32 = F.lane & 31, hi = F.lane >> 5;
#pragma unroll
    for (int tj = 0; tj < 2; ++tj) {
        f32x16 s = {};
#pragma unroll
        for (int kk = 0; kk < 4; ++kk) {
            const bf16x8 a = *(const LAS bf16x8*)(Qs + (32 * ti + r32) * RS_K + 16 * kk + 8 * hi);
            const bf16x8 bb = *(const LAS bf16x8*)(Ks + (32 * tj + r32) * RS_K + 16 * kk + 8 * hi);
            s = __builtin_amdgcn_mfma_f32_32x32x16_bf16(a, bb, s, 0, 0, 0);
        }
#pragma unroll
        for (int r = 0; r < 16; ++r) { const int il = (r & 3) + 8 * (r >> 2) + 4 * hi; const int dd = (32 * ti + il) - (32 * tj + r32);
            Sw[il * RS_K + 32 * tj + r32] = (u16)f2bf(s[r] * __expf(lg * fabsf((float)dd))); }
    }
    LDS_WAIT();
    f32x16 y = {}, cr = {};
#pragma unroll
    for (int kk = 0; kk < 4; ++kk) {
        const bf16x8 a = *(const LAS bf16x8*)(Sw + r32 * RS_K + 16 * kk + 8 * hi);
        const bf16x8 bb = gather8(Vs + (16 * kk + 8 * hi) * RS_V + 32 * te + r32, RS_V);
        y = __builtin_amdgcn_mfma_f32_32x32x16_bf16(a, bb, y, 0, 0, 0);
        const bf16x8 a2 = *(const LAS bf16x8*)(Qs + (32 * ti + r32) * RS_K + 16 * kk + 8 * hi);
        const bf16x8 b2 = gather8(Ps + (16 * kk + 8 * hi) * RS_V + 32 * te + r32, RS_V);
        cr = __builtin_amdgcn_mfma_f32_32x32x16_bf16(a2, b2, cr, 0, 0, 0);
    }
#pragma unroll
    for (int r = 0; r < 16; ++r) { const int i = 32 * ti + (r & 3) + 8 * (r >> 2) + 4 * hi;
        Ys[i * 132 + 32 * te + r32] = y[r] + cr[r] * __expf(lg * (float)(i + 1)); }

    LDS_WAIT(); __builtin_amdgcn_s_barrier();
    { const int i = F.tid >> 3, sg = (F.tid & 7) * 16;
      float v[16]; float s = 0.f;
#pragma unroll
      for (int q = 0; q < 4; ++q) { const f32x4 t = *(const LAS f32x4*)(Ys + i * 132 + sg + 4 * q); v[4 * q] = t[0]; v[4 * q + 1] = t[1]; v[4 * q + 2] = t[2]; v[4 * q + 3] = t[3]; s += (t[0] + t[1]) + (t[2] + t[3]); }
      s += dppf<0xB1>(s); s += dppf<0x4E>(s); s += dppf<0x141>(s);
      const float mu = s * (1.f / 128.f); float q2 = 0.f;
#pragma unroll
      for (int q = 0; q < 16; ++q) { v[q] -= mu; q2 += v[q] * v[q]; }
      q2 += dppf<0xB1>(q2); q2 += dppf<0x4E>(q2); q2 += dppf<0x141>(q2);
      const float rstd = 1.0f / sqrtf(q2 * (1.f / 128.f) + EPS);
      const u32x4 g0 = *(const u32x4*)(RGp + (size_t)i * 512 + sg), g1 = *(const u32x4*)(RGp + (size_t)i * 512 + sg + 8);
      const unsigned gw_[8] = {g0.x, g0.y, g0.z, g0.w, g1.x, g1.y, g1.z, g1.w};
      unsigned ow[8];
#pragma unroll
      for (int q = 0; q < 8; ++q) { const float a = v[2 * q] * rstd * gn[sg + 2 * q] * bf2f(gw_[q] & 0xffffu), bq = v[2 * q + 1] * rstd * gn[sg + 2 * q + 1] * bf2f(gw_[q] >> 16); ow[q] = cvt_pk_bf16(a, bq); }
      *(u32x4*)(YR + (size_t)i * 512 + sg) = (u32x4){ow[0], ow[1], ow[2], ow[3]}; *(u32x4*)(YR + (size_t)i * 512 + sg + 8) = (u32x4){ow[4], ow[5], ow[6], ow[7]}; }
    LDS_WAIT(); __builtin_amdgcn_s_barrier();
}

__device__ __forceinline__ void bt16(unsigned (&x)[16]) {
#pragma unroll
    for (int j = 0; j < 8; ++j) { const unsigned a = x[j], b = x[j + 8]; x[j] = __builtin_amdgcn_perm(b, a, 0x06020400u); x[j + 8] = __builtin_amdgcn_perm(b, a, 0x07030501u); }
#define BT_STAGE(s, m) _Pragma("unroll") for (int j = 0; j < 16; ++j) if (!(j & s)) { const unsigned a = x[j], b = x[j + s]; x[j] = (a & m) | ((b << s) & ~m); x[j + s] = ((a >> s) & m) | (b & ~m); }
    BT_STAGE(4, 0x0F0F0F0Fu) BT_STAGE(2, 0x33333333u) BT_STAGE(1, 0x55555555u)
#undef BT_STAGE
}
__device__ __forceinline__ float relu_s(float x) { return __builtin_amdgcn_fmed3f(x, 0.0f, 3.0e38f); }
constexpr int IDX_WST = 131072;
struct IdxPre { f16x8 qa[4]; f32x4 wv[4]; f16x8 b0[2][4], b1[2][4]; };
__device__ __forceinline__ void idx_prefetch(Frame& F, int grp, IdxPre& P) {
    const int b = grp >> 10, t0 = (grp & 1023) * 8, ntile32 = 2 * ((t0 >> 6) + 1);
    const size_t tokbase = (size_t)b * SEQ;
    const int lane = F.lane, wid = F.wave, r32 = lane & 31, hi = lane >> 5;
    const _Float16* IQ = (const _Float16*)(F.ws + WS_IQ); const _Float16* IK = (const _Float16*)(F.ws + WS_IK); const float* IW = (const float*)(F.ws + WS_IW);
    const _Float16* qp = IQ + (tokbase + t0 + (r32 >> 2)) * 256 + (r32 & 3) * 64 + 8 * hi;
#pragma unroll
    for (int kk = 0; kk < 4; ++kk) P.qa[kk] = *(const f16x8*)(qp + 16 * kk);
#pragma unroll
    for (int jq = 0; jq < 4; ++jq) P.wv[jq] = *(const f32x4*)(IW + (tokbase + t0 + 2 * jq + hi) * 4) * 1024.0f;
#pragma unroll
    for (int u = 0; u < 2; ++u) {
        const int Ta_ = wid + NWAVES * u, Tb_ = wid + NWAVES * (2 + u);
        const int Ta = Ta_ < ntile32 ? Ta_ : ntile32 - 1, Tb = Tb_ < ntile32 ? Tb_ : ntile32 - 1;
        const _Float16* ka = IK + ((tokbase >> 5) + Ta) * 2048 + lane * 8; const _Float16* kb = IK + ((tokbase >> 5) + Tb) * 2048 + lane * 8;
#pragma unroll
        for (int kk = 0; kk < 4; ++kk) { P.b0[u][kk] = *(const f16x8*)(ka + 512 * kk); P.b1[u][kk] = *(const f16x8*)(kb + 512 * kk); }
    }
}
__device__ __forceinline__ void indexer_group(Frame& F, int grp, int nxt, IdxPre& P) {
    const int b = grp >> 10, g8 = grp & 1023, t0 = g8 * 8, chunk = t0 >> 6, nt64 = chunk + 1;
    const size_t tokbase = (size_t)b * SEQ;
    const int nwords = 4 * (chunk >> 2) + 4;
    unsigned long long* BMp = (unsigned long long*)((unsigned char*)F.out + OUT_BM);
    LAS u16* sc = (LAS u16*)F.lds;
    LAS unsigned long long* wst = (LAS unsigned long long*)(F.lds + IDX_WST);
    const int lane = F.lane, wid = F.wave, r32 = lane & 31, hi = lane >> 5;
    if (nt64 <= 4) {
        if (F.tid < nwords * 4) { const int i = F.tid >> 2, part = F.tid & 3; const unsigned long long w = (i < nt64) ? ~0ull : 0ull;
            unsigned long long* dst = BMp + ((size_t)(b * 128 + i) * SEQ + t0 + 2 * part); dst[0] = w; dst[1] = w; }
        idx_prefetch(F, nxt, P);
        return;
    }
    {
        const _Float16* IK = (const _Float16*)(F.ws + WS_IK);
        f16x8 (&qa)[4] = P.qa; f32x4 (&wv)[4] = P.wv;
        const int ntile32 = nt64 * 2;
        const int rotl = 2 * (r32 & 15) + hi, lofs = hi * 8192 + (r32 & 15) * 128 + (r32 >> 4);
#define IDX_LOAD(buf, trip) do { _Pragma("unroll") for (int u = 0; u < 2; ++u) { const int T_ = wid + NWAVES * (2 * (trip) + u); const int T = T_ < ntile32 ? T_ : ntile32 - 1; { const _Float16* kp = IK + ((tokbase >> 5) + T) * 2048 + lane * 8; \
            _Pragma("unroll") for (int kk = 0; kk < 4; ++kk) buf[u][kk] = *(const f16x8*)(kp + 512 * kk); } } } while (0)
#define IDX_COMP(buf, trip) do { _Pragma("unroll") for (int u = 0; u < 2; ++u) { const int T_ = wid + NWAVES * (2 * (trip) + u); const int T = T_ < ntile32 ? T_ : ntile32 - 1; { \
            f32x16 acc = {}; \
            _Pragma("unroll") for (int kk = 0; kk < 4; ++kk) acc = __builtin_amdgcn_mfma_f32_32x32x16_f16(qa[kk], buf[u][kk], acc, 0, 0, 0); \
            const int wofs = (((T >> 6) * 16 * 64 + (((T & 63) + rotl) & 63)) << 1) + lofs;        \
            _Pragma("unroll") for (int jq = 0; jq < 4; ++jq) { \
                float s = __builtin_fmaf(wv[jq][0], relu_s(acc[4 * jq]), 49152.0f); \
                s = __builtin_fmaf(wv[jq][1], relu_s(acc[4 * jq + 1]), s); s = __builtin_fmaf(wv[jq][2], relu_s(acc[4 * jq + 2]), s); s = __builtin_fmaf(wv[jq][3], relu_s(acc[4 * jq + 3]), s); \
                  \
                const unsigned kq = (unsigned)__builtin_amdgcn_fmed3f(s, 32768.0f, 65535.0f);        \
                sc[2 * jq * 8192 + wofs] = (u16)kq; } } } } while (0)
        {
            const int ntrips = (ntile32 + 2 * NWAVES - 1) / (2 * NWAVES);
            f16x8 (&b0)[2][4] = P.b0; f16x8 (&b1)[2][4] = P.b1; f16x8 b2[2][4];
            {
            for (int i = 0; i < ntrips; i += 3) {
                IDX_LOAD(b2, i + 2); IDX_COMP(b0, i);
                if (i + 1 >= ntrips) break;
                IDX_LOAD(b0, i + 3); IDX_COMP(b1, i + 1);
                if (i + 2 >= ntrips) break;
                IDX_LOAD(b1, i + 4); IDX_COMP(b2, i + 2);
            }
            }
        }
#undef IDX_LOAD
#undef IDX_COMP
    }
    idx_prefetch(F, nxt, P);
    LDS_WAIT(); __builtin_amdgcn_s_barrier();
    {
        const int nblk = 2 * nt64;
        const LAS unsigned* row = (const LAS unsigned*)(sc + wid * 8192);
        unsigned P[4][16];
#pragma unroll
        for (int c = 0; c < 4; ++c) {
            if (c * 64 < nblk) {
                const bool valid = c * 64 + lane < nblk;
#pragma unroll
                for (int j = 0; j < 16; ++j) { const unsigned v = row[(c * 16 + j) * 64 + ((lane + 2 * j + (wid & 1)) & 63)]; P[c][j] = valid ? v : 0u; }
                bt16(P[c]);
            } else {
#pragma unroll
                for (int j = 0; j < 16; ++j) P[c][j] = 0u;
            }
        }
        unsigned A[4], G[4];
#pragma unroll
        for (int c = 0; c < 4; ++c) { A[c] = P[c][15]; G[c] = 0u; }
        int cntG = 0;
#pragma unroll
        for (int bit = 14; bit >= 0; --bit) {
            unsigned t[4]; int n = 0;
#pragma unroll
            for (int c = 0; c < 4; ++c) { t[c] = A[c] & P[c][bit]; n += (int)__builtin_popcount(t[c]); }
            const int n1 = __builtin_amdgcn_readfirstlane(wave_sum_i(n));
            if (cntG + n1 >= 256) {
#pragma unroll
                for (int c = 0; c < 4; ++c) A[c] = t[c];
            } else {
#pragma unroll
                for (int c = 0; c < 4; ++c) { G[c] |= t[c]; A[c] ^= t[c]; }
                cntG += n1;
            }
        }
        const int need = 256 - cntG;
        int na = 0;
#pragma unroll
        for (int c = 0; c < 4; ++c) na += (int)__builtin_popcount(A[c]);
        const int ntie = __builtin_amdgcn_readfirstlane(wave_sum_i(na));
        if (ntie > need) {
            int run = 0;
#pragma unroll
            for (int c = 0; c < 4; ++c) {
                const int pc = (int)__builtin_popcount(A[c]);
                int incl = pc;
#pragma unroll
                for (int o = 1; o < 64; o <<= 1) { const int v = __shfl_up(incl, o); if (lane >= o) incl += v; }
                int k = need - (run + incl - pc); k = k < 0 ? 0 : k;
                unsigned av = A[c];
                while ((int)__builtin_popcount(av) > k) av &= ~(0x80000000u >> __builtin_clz(av));
                A[c] = av;
                run += __builtin_amdgcn_readlane(incl, 63);
            }
        }
        LAS unsigned* wst32 = (LAS unsigned*)wst;
#pragma unroll
        for (int c = 0; c < 4; ++c) wst32[((c * 32 + (lane >> 1)) * 8 + wid) * 2 + (lane & 1)] = G[c] | A[c];
    }
    LDS_WAIT(); __builtin_amdgcn_s_barrier();
    if (F.tid < nwords * 4) { const int i = F.tid >> 2, part = F.tid & 3;
        const unsigned long long a = wst[i * 8 + 2 * part], c = wst[i * 8 + 2 * part + 1];
        unsigned long long* dst = BMp + ((size_t)(b * 128 + i) * SEQ + t0 + 2 * part); dst[0] = a; dst[1] = c; }
}

__device__ __forceinline__ float dot2bf(unsigned a, unsigned b, float c) { return __builtin_amdgcn_fdot2_f32_bf16(__builtin_bit_cast(bf16x2v, a), __builtin_bit_cast(bf16x2v, b), c, false); }
__device__ __forceinline__ unsigned f16key(unsigned bits) { return (bits & 0x8000u) ? (~bits & 0xffffu) : (bits | 0x8000u); }
__device__ __forceinline__ float f16key_val(unsigned key) { const unsigned bits = (key & 0x8000u) ? (key & 0x7fffu) : (~key & 0xffffu); return (float)__builtin_bit_cast(_Float16, (u16)bits); }
__device__ __forceinline__ unsigned f32key(float f) { const unsigned u = __builtin_bit_cast(unsigned, f); return (u & 0x80000000u) ? ~u : (u | 0x80000000u); }
#define CE(a, b) do { const unsigned _x = a > b ? a : b, _y = a > b ? b : a; a = _x; b = _y; } while (0)
__device__ __forceinline__ void top16_of_128(const u32x4 raw, int li, float& val, int& idx) {
    unsigned e[8];
    const unsigned w[4] = {raw.x, raw.y, raw.z, raw.w};
#pragma unroll
    for (int q = 0; q < 4; ++q) { e[2 * q] = (f16key(w[q] & 0xffffu) << 16) | (unsigned)(li * 8 + 2 * q); e[2 * q + 1] = (f16key(w[q] >> 16) << 16) | (unsigned)(li * 8 + 2 * q + 1); }
    CE(e[0], e[1]); CE(e[2], e[3]); CE(e[4], e[5]); CE(e[6], e[7]);
    CE(e[0], e[2]); CE(e[1], e[3]); CE(e[4], e[6]); CE(e[5], e[7]);
    CE(e[1], e[2]); CE(e[5], e[6]); CE(e[0], e[4]); CE(e[3], e[7]);
    CE(e[1], e[5]); CE(e[2], e[6]);
    CE(e[1], e[4]); CE(e[3], e[6]);
    CE(e[2], e[4]); CE(e[3], e[5]);
    CE(e[3], e[4]);
    unsigned mine = 0;
#pragma unroll
    for (int r = 0; r < 16; ++r) {
        const unsigned M = row16_maxu(e[0]);
        if (li == r) mine = M;
        if (e[0] == M) { e[0] = e[1]; e[1] = e[2]; e[2] = e[3]; e[3] = e[4]; e[4] = e[5]; e[5] = e[6]; e[6] = e[7]; e[7] = 0u; }
    }
    val = f16key_val(mine >> 16); idx = (int)(mine & 127u);
}
constexpr int PEER_T = 4;
constexpr int PEER_NSL = 16;
constexpr int PEER_SLSH = 10;
constexpr int PEER_WSC = 1024 + 256 + PEER_T * (1024 + 2048);
__device__ __forceinline__ void peer_select16(const _Float16* SCp, int lane, LAS unsigned* sel) {
    typedef short s16x2_t __attribute__((ext_vector_type(2)));
    const int p = lane & 3;
    unsigned D[16];
    { const u32x4* src = (const u32x4*)SCp + 4 * lane;
#pragma unroll
      for (int q = 0; q < 4; ++q) { const u32x4 v = src[q]; D[4 * q] = v.x; D[4 * q + 1] = v.y; D[4 * q + 2] = v.z; D[4 * q + 3] = v.w; } }
#pragma unroll
    for (int i = 0; i < 16; ++i) { const s16x2_t h = __builtin_bit_cast(s16x2_t, D[i]); const s16x2_t sh = {15, 15};
        D[i] ^= (__builtin_bit_cast(unsigned, h >> sh) | 0x80008000u); }
    unsigned X[16];
#pragma unroll
    for (int j = 0; j < 16; ++j) X[j] = __builtin_amdgcn_perm(D[8 + (j >> 1)], D[j >> 1], (j & 1) ? 0x07060302u : 0x05040100u);
    bt16(X);
    unsigned A = ~0u, G = 0u; int cntG = 0;
#pragma unroll
    for (int b = 15; b >= 0; --b) {
        const unsigned t = A & X[b]; int n = (int)__builtin_popcount(t);
        n += dppi<0xB1>(n); n += dppi<0x4E>(n);
        const bool take = cntG + n >= 16;
        A = take ? t : (A ^ t); G = take ? G : (G | t); cntG = take ? cntG : cntG + n;
    }
    { const int tc = (int)__builtin_popcount(A);
      const int t0 = dppi<0x00>(tc), t1 = dppi<0x55>(tc), t2 = dppi<0xAA>(tc);
      const int ex = (p > 0 ? t0 : 0) + (p > 1 ? t1 : 0) + (p > 2 ? t2 : 0);
      int k = 16 - cntG - ex; k = k < 0 ? 0 : (k > tc ? tc : k);
      while ((int)__builtin_popcount(A) > k) A &= ~(0x80000000u >> __builtin_clz(A)); }
    unsigned S = G | A;
    { const int sc = (int)__builtin_popcount(S);
      const int t0 = dppi<0x00>(sc), t1 = dppi<0x55>(sc), t2 = dppi<0xAA>(sc);
      int pos = (lane >> 2) * 16 + (p > 0 ? t0 : 0) + (p > 1 ? t1 : 0) + (p > 2 ? t2 : 0);
      while (S) { const int m = __builtin_ctz(S); S &= S - 1u; sel[pos] = (unsigned)(32 * p + m); ++pos; } }
}
__device__ __forceinline__ void peer_route(Frame& F, int tok, LAS float* wsc, LAS float* tls, int& cvec) {
    const int lane = F.lane, gq = lane >> 4, li = lane & 15;
    const float* ffn_norm = F.in[7];
    const u16* xrow = (const u16*)(F.ws + WS_X1B) + (size_t)tok * DMODEL;
    const _Float16* SCp = (const _Float16*)(F.ws + WS_SC) + (size_t)tok * 2048;
    f32x4 xv[4]; float ss = 0.f;
    { const u32x4 r0 = *(const u32x4*)(xrow + 16 * lane), r1 = *(const u32x4*)(xrow + 16 * lane + 8);
      const unsigned w[8] = {r0.x, r0.y, r0.z, r0.w, r1.x, r1.y, r1.z, r1.w};
#pragma unroll
      for (int q = 0; q < 4; ++q) { xv[q][0] = bf2f(w[2 * q] & 0xffffu); xv[q][1] = bf2f(w[2 * q] >> 16); xv[q][2] = bf2f(w[2 * q + 1] & 0xffffu); xv[q][3] = bf2f(w[2 * q + 1] >> 16); } }
#pragma unroll
    for (int q = 0; q < 4; ++q) ss += (xv[q][0] * xv[q][0] + xv[q][1] * xv[q][1]) + (xv[q][2] * xv[q][2] + xv[q][3] * xv[q][3]);
    const float rstd2 = 1.0f / sqrtf(wave_sum(ss) * (1.f / DMODEL) + EPS);
#pragma unroll
    for (int q = 0; q < 4; ++q) { const f32x4 g = *(const f32x4*)(ffn_norm + 16 * lane + 4 * q);
        ((LAS unsigned*)tls)[256 + (2 * q) * 64 + lane] = cvt_pk_bf16(xv[q][0] * rstd2 * g[0], xv[q][1] * rstd2 * g[1]); ((LAS unsigned*)tls)[256 + (2 * q + 1) * 64 + lane] = cvt_pk_bf16(xv[q][2] * rstd2 * g[2], xv[q][3] * rstd2 * g[3]); }
    int ex[2]; float gt[2]; unsigned exk[2];
    LAS float* aval = wsc; LAS int* aidx = (LAS int*)(wsc + 64); LAS float* bval = wsc + 128; LAS int* bidx = (LAS int*)(wsc + 192);
    const int ci2 = li <= 6 ? 1 : (li <= 10 ? 2 : (li <= 13 ? 3 : 4)), cj2 = li <= 6 ? li + 1 : (li <= 10 ? li - 6 : (li <= 13 ? li - 10 : li - 13));
    LAS unsigned* sel = (LAS unsigned*)tls;
    peer_select16(SCp, lane, sel);
    LDS_WAIT();
#pragma unroll
    for (int R = 0; R < 2; ++R) {
        const int hh = 4 * R + gq;
        const int rb16 = gq * 16;
        float av, bv; int ai, bi;
        {
            const int ia = (int)sel[(2 * hh) * 16 + li], ib = (int)sel[(2 * hh + 1) * 16 + li];
            const unsigned sa = ((const u16*)SCp)[(2 * hh) * 128 + ia], sb = ((const u16*)SCp)[(2 * hh + 1) * 128 + ib];
            const unsigned ka = (f16key(sa) << 16) | (unsigned)ia, kb = (f16key(sb) << 16) | (unsigned)ib;
            int ra_ = 0, rb_ = 0;
#define PEER_ROT(sft) { const unsigned xa = (unsigned)dppi<0x120 + sft>((int)ka), xb = (unsigned)dppi<0x120 + sft>((int)kb); ra_ += xa > ka ? 1 : 0; rb_ += xb > kb ? 1 : 0; }
            PEER_ROT(1) PEER_ROT(2) PEER_ROT(3) PEER_ROT(4) PEER_ROT(5) PEER_ROT(6) PEER_ROT(7) PEER_ROT(8) PEER_ROT(9) PEER_ROT(10) PEER_ROT(11) PEER_ROT(12) PEER_ROT(13) PEER_ROT(14) PEER_ROT(15)
#undef PEER_ROT
            aval[rb16 + ra_] = f16key_val(ka >> 16); aidx[rb16 + ra_] = ia; bval[rb16 + rb_] = f16key_val(kb >> 16); bidx[rb16 + rb_] = ib;
            av = aval[lane]; ai = aidx[lane]; bv = bval[lane]; bi = bidx[lane];
        }
        const float a0 = aval[rb16], b0 = bval[rb16], a2 = aval[rb16 + ci2], b2 = bval[rb16 + cj2], a3 = aval[rb16 + ((5 + li) & 15)], b1 = bval[rb16 + 1];
        unsigned e0 = (f32key(a0 + bv) & ~63u) | (unsigned)li;
        unsigned e1 = li >= 1 ? ((f32key(av + b0) & ~63u) | (unsigned)(16 + li)) : 0u;
        unsigned e2 = (f32key(a2 + b2) & ~63u) | (unsigned)(32 + li);
        unsigned e3 = li <= 2 ? ((f32key(a3 + b1) & ~63u) | (unsigned)(48 + li)) : 0u;
        CE(e0, e1); CE(e2, e3); CE(e0, e2); CE(e1, e3); CE(e1, e2);
        unsigned mine = 0u;
#pragma unroll
        for (int r = 0; r < 16; ++r) {
            const unsigned M = row16_maxu(e0);
            if (li == r) mine = M;
            if (e0 == M) { e0 = e1; e1 = e2; e2 = e3; e3 = 0u; }
        }
        const int sub = (int)((mine >> 4) & 3u), sl = (int)(mine & 15u);
        const int si2 = sl <= 6 ? 1 : (sl <= 10 ? 2 : (sl <= 13 ? 3 : 4)), sj2 = sl <= 6 ? sl + 1 : (sl <= 10 ? sl - 6 : (sl <= 13 ? sl - 10 : sl - 13));
        const int wi = sub == 0 ? 0 : (sub == 1 ? sl : (sub == 2 ? si2 : 5 + sl)), wj = sub == 0 ? sl : (sub == 1 ? 0 : (sub == 2 ? sj2 : 1));
        const float sm = aval[rb16 + wi] + bval[rb16 + wj]; ex[R] = aidx[rb16 + wi] * 128 + bidx[rb16 + wj];
        const unsigned kuv = ((const unsigned*)(F.ws + WS_KUV))[ex[R]];
        const float mx = row16_max(sm);
        const float ee = __expf(rstd2 * (sm - mx));
        gt[R] = ldexpf(ee / row16_sum(ee), 64 - (int)((kuv >> 8) & 0xffu));
        exk[R] = (unsigned)ex[R] * 768u | ((kuv & 0xffu) << 24);
    }
    LAS int* cnt = (LAS int*)wsc; LAS int* offs = (LAS int*)(wsc + 64);
    LAS int* sex = (LAS int*)tls; LAS float* sgt = tls + 128;
    cnt[lane] = 0;
    const int s0 = ex[0] >> PEER_SLSH, s1 = ex[1] >> PEER_SLSH;
    const int r0 = __hip_atomic_fetch_add(&cnt[s0], 1, __ATOMIC_RELAXED, __HIP_MEMORY_SCOPE_WORKGROUP);
    const int r1 = __hip_atomic_fetch_add(&cnt[s1], 1, __ATOMIC_RELAXED, __HIP_MEMORY_SCOPE_WORKGROUP);
    const int c0 = cnt[lane]; int c = c0;
#pragma unroll
    for (int o = 1; o < 64; o <<= 1) { const int t = __shfl_up(c, o, 64); if (lane >= o) c += t; }
    offs[lane] = c - c0;
    cvec = c;
    const int p0 = offs[s0] + r0, p1 = offs[s1] + r1;
    sex[p0] = (int)exk[0]; sgt[p0] = gt[0]; sex[p1] = (int)exk[1]; sgt[p1] = gt[1];
}
typedef unsigned v6u32 __attribute__((ext_vector_type(6)));
typedef __bf16 v32bf __attribute__((ext_vector_type(32)));
typedef float v32f __attribute__((ext_vector_type(32)));
__device__ __forceinline__ void peer_batch(const unsigned char* U6, const unsigned char* V6, int lane, int b, const LAS float* tls, float (&acc)[16]) {
    const LAS unsigned* sex = (const LAS unsigned*)tls; const LAS float* sgt = tls + 128;
    typedef unsigned v2u32_t __attribute__((ext_vector_type(2)));
    typedef unsigned v3u32_t __attribute__((ext_vector_type(3)));
    const __amdgpu_buffer_rsrc_t ru = __builtin_amdgcn_make_buffer_rsrc((void*)U6, 0, 0x7fffffff, 0x00020000);
    const __amdgpu_buffer_rsrc_t rv = __builtin_amdgcn_make_buffer_rsrc((void*)V6, 0, 0x7fffffff, 0x00020000);
    const int lofs = 12 * lane;
    v6u32 pku[4], pkv[4];
    __builtin_amdgcn_s_setprio(2);

#pragma unroll
    for (int jj = 0; jj < 4; ++jj) {
        const int e0 = (int)((unsigned)__builtin_amdgcn_readfirstlane((int)sex[8 * b + 2 * jj]) & 0xffffffu), e1 = (int)((unsigned)__builtin_amdgcn_readfirstlane((int)sex[8 * b + 2 * jj + 1]) & 0xffffffu);
        { const v3u32_t a = __builtin_amdgcn_raw_buffer_load_b96(ru, lofs, e0, 0); const unsigned bx = __builtin_amdgcn_raw_buffer_load_b32(ru, lofs, e1, 0); const v2u32_t byz = __builtin_amdgcn_raw_buffer_load_b64(ru, lofs + 4, e1, 0);
          pku[jj] = (v6u32){a.x, a.y, a.z, bx, byz.x, byz.y}; }
        { const v3u32_t a = __builtin_amdgcn_raw_buffer_load_b96(rv, lofs, e0, 0); const unsigned bx = __builtin_amdgcn_raw_buffer_load_b32(rv, lofs, e1, 0); const v2u32_t byz = __builtin_amdgcn_raw_buffer_load_b64(rv, lofs + 4, e1, 0);
          pkv[jj] = (v6u32){a.x, a.y, a.z, bx, byz.x, byz.y}; }
    }
    unsigned hp[8];
#pragma unroll
    for (int k = 0; k < 8; ++k) hp[k] = ((const LAS unsigned*)tls)[256 + k * 64 + lane];
    __builtin_amdgcn_s_setprio(0);
    float d[8];
#pragma unroll
    for (int jj = 0; jj < 4; ++jj) {
        const v32bf r = __builtin_amdgcn_cvt_scalef32_pk32_bf16_fp6(pku[jj], 1.0f);
        float s0 = 0.f, s1 = 0.f;
#pragma unroll
        for (int k = 0; k < 8; ++k) {
            const bf16x2v x0 = {r[2 * k], r[2 * k + 1]}, x1 = {r[16 + 2 * k], r[17 + 2 * k]};
            s0 = __builtin_amdgcn_fdot2_f32_bf16(x0, __builtin_bit_cast(bf16x2v, hp[k]), s0, false);
            s1 = __builtin_amdgcn_fdot2_f32_bf16(x1, __builtin_bit_cast(bf16x2v, hp[k]), s1, false);
        }
        d[2 * jj] = s0; d[2 * jj + 1] = s1;
    }
    float t4[4], t2[2], t1;
    { const bool up = lane & 4;
#pragma unroll
      for (int k = 0; k < 4; ++k) { const float keep = up ? d[4 + k] : d[k], send = up ? d[k] : d[4 + k]; t4[k] = keep + dppf<0x141>(send); } }
    { const bool up = lane & 1;
#pragma unroll
      for (int k = 0; k < 2; ++k) { const float keep = up ? t4[2 + k] : t4[k], send = up ? t4[k] : t4[2 + k]; t2[k] = keep + dppf<0xB1>(send); } }
    { const bool up = lane & 2; const float keep = up ? t2[1] : t2[0], send = up ? t2[0] : t2[1]; t1 = keep + dppf<0x4E>(send); }
    t1 += dppf<0x128>(t1);
    { auto r = __builtin_amdgcn_permlane16_swap(__float_as_uint(t1), __float_as_uint(t1), false, false); const unsigned r0 = r[0], r1 = r[1]; t1 = __uint_as_float(r0) + __uint_as_float(r1); }
    { auto r = __builtin_amdgcn_permlane32_swap(__float_as_uint(t1), __float_as_uint(t1), false, false); const unsigned r0 = r[0], r1 = r[1]; t1 = __uint_as_float(r0) + __uint_as_float(r1); }
    const int myj = 4 * ((lane >> 2) & 1) + 2 * (lane & 1) + ((lane >> 1) & 1);
    const float g = sgt[8 * b + myj];
    const int ku = (int)(sex[8 * b + myj] >> 24) - 64;
    const float coef = g * gelu_erf(ldexpf(t1, -ku));
#pragma unroll
    for (int jj = 0; jj < 4; ++jj) {
        const int j0 = 2 * jj, j1 = 2 * jj + 1;
        const int src0 = 4 * (j0 >> 2) + ((j0 >> 1) & 1) + 2 * (j0 & 1), src1 = 4 * (j1 >> 2) + ((j1 >> 1) & 1) + 2 * (j1 & 1);
        const float c0 = __builtin_bit_cast(float, __builtin_amdgcn_readlane(__builtin_bit_cast(int, coef), src0));
        const float c1 = __builtin_bit_cast(float, __builtin_amdgcn_readlane(__builtin_bit_cast(int, coef), src1));
        const v32f r = __builtin_amdgcn_cvt_scalef32_pk32_f32_fp6(pkv[jj], 1.0f);
#pragma unroll
        for (int i = 0; i < 16; ++i) { acc[i] = __builtin_fmaf(c0, r[i], acc[i]); acc[i] = __builtin_fmaf(c1, r[16 + i], acc[i]); }
        __builtin_amdgcn_sched_barrier(0);
    }
}
__device__ __forceinline__ void peer_finish(Frame& F, int tok, const float (&acc)[16]) {
    const int lane = F.lane; const float* fin_norm = F.in[12];
    float* orow = F.out + (size_t)tok * DMODEL; const u16* xrow = (const u16*)(F.ws + WS_X1B) + (size_t)tok * DMODEL;
    f32x4 o[4]; float s2 = 0.f;
    { const u32x4 r0 = *(const u32x4*)(xrow + 16 * lane), r1 = *(const u32x4*)(xrow + 16 * lane + 8);
      const unsigned w[8] = {r0.x, r0.y, r0.z, r0.w, r1.x, r1.y, r1.z, r1.w};
#pragma unroll
      for (int q = 0; q < 4; ++q) { o[q][0] = bf2f(w[2 * q] & 0xffffu); o[q][1] = bf2f(w[2 * q] >> 16); o[q][2] = bf2f(w[2 * q + 1] & 0xffffu); o[q][3] = bf2f(w[2 * q + 1] >> 16); } }
#pragma unroll
    for (int q = 0; q < 4; ++q)
#pragma unroll
        for (int j = 0; j < 4; ++j) { o[q][j] += acc[4 * q + j]; s2 += o[q][j] * o[q][j]; }
    const float rs = 1.0f / sqrtf(wave_sum(s2) * (1.f / DMODEL) + EPS);
#pragma unroll
    for (int q = 0; q < 4; ++q) { const f32x4 fn = *(const f32x4*)(fin_norm + 16 * lane + 4 * q); f32x4 r;
#pragma unroll
        for (int j = 0; j < 4; ++j) r[j] = o[q][j] * rs * fn[j];
        *(f32x4*)(orow + 16 * lane + 4 * q) = r; }
}
constexpr int CW_PQ = 7680;
__device__ __forceinline__ unsigned peer_group(Frame& F, int g, LAS float* wsc, unsigned* q) {
    const unsigned char* U8 = (const unsigned char*)(F.ws + WS_U); const unsigned char* V8 = (const unsigned char*)(F.ws + WS_V);
    int cvec[PEER_T]; float acc[PEER_T][16]; int nb[PEER_T];
#pragma unroll
    for (int t = 0; t < PEER_T; ++t) { peer_route(F, g * PEER_T + t, wsc, wsc + 320 + t * 768, cvec[t]); nb[t] = 0;
#pragma unroll
        for (int i = 0; i < 16; ++i) acc[t][i] = 0.f; }
#pragma unroll 1
    for (int s = 0; s < PEER_NSL; ++s) {
#pragma unroll
        for (int t = 0; t < PEER_T; ++t) {
            const int cs = __builtin_amdgcn_readlane(cvec[t], s);
            while (8 * (nb[t] + 1) <= cs) { peer_batch(U8, V8, F.lane, nb[t], wsc + 320 + t * 768, acc[t]); ++nb[t]; }
        }
    }
    unsigned tk = 0u;
    if (q) { if (F.lane == 0) tk = xb_add(q, 1u); }
#pragma unroll
    for (int t = 0; t < PEER_T; ++t) peer_finish(F, g * PEER_T + t, acc[t]);
    return (unsigned)__builtin_amdgcn_readfirstlane((int)tk);
}

#ifndef MK_N_LAUNCHES
#define MK_N_LAUNCHES 1
#endif
constexpr int N_PHASES = 9;
constexpr int N_LAUNCHES = MK_N_LAUNCHES;
constexpr int CW_BAR = 4096;

struct Args { const float* in[13]; float* out; unsigned char* ws; int ph_lo, ph_hi, li, pad; };

__global__ void __launch_bounds__(NWAVES * 64, 2) mk_fwd(Args args) {
    extern __shared__ __attribute__((aligned(16))) unsigned char lds[];
    Frame F;
    F.lds = (LAS unsigned char*)lds; F.ldsg = lds;
    F.tid = threadIdx.x; F.lane = F.tid & 63; F.wave = __builtin_amdgcn_readfirstlane(F.tid >> 6);
    F.G = gridDim.x; { const int bx = blockIdx.x; F.vcu = (F.G % 8 == 0) ? (bx % 8) * (F.G / 8) + bx / 8 : bx; }
#pragma unroll
    for (int i = 0; i < 13; ++i) F.in[i] = args.in[i];
    F.out = args.out; F.ws = args.ws;
    volatile LAS unsigned* MISC = (volatile LAS unsigned*)(F.lds + MISC_OFF);
    for (int u = F.tid; u < (LDS_BYTES - LDSCTL_OFF) / 4; u += NWAVES * 64) ((LAS unsigned*)(F.lds + LDSCTL_OFF))[u] = 0u;
    __syncthreads();
    unsigned* ctl = (unsigned*)(F.ws + WS_CTL);
    XcdBarrier bar; bar.bar = ctl + CW_BAR; bar.x = 0; bar.st = nullptr;
    if (N_LAUNCHES == 1) bar = xcd_barrier_post(ctl + CW_BAR, MISC + 8);
    const int lo = args.ph_lo, hi = args.ph_hi;
#ifndef PH_MASK
#define PH_MASK 0x1FF
#endif
#define IN(k) (((PH_MASK >> (k)) & 1) && lo <= (k) && (k) < hi)
#define SEAM(k) do { if (IN(k) && IN((k) + 1)) xcd_barrier(bar); } while (0)

    if (IN(0)) { p0_prologue(F); }
    SEAM(0);
    if (IN(1)) {
        pg8::Desc S{}; S.A0 = (const u16*)(F.ws + WS_XB); S.B0 = (const u16*)(F.ws + WS_WIN); S.A1 = S.A0; S.B1 = S.B0;
        S.K = 1024; S.nM = NTOK / 256; S.nN = N1PAD / 256; S.nsub = 1; S.G = F.G; S.c = (int)blockIdx.x; S.mode = pg8::M_PROJ; S.ws = F.ws; S.xin = nullptr; S.out = nullptr;
        pg8::gemm_phase(F.lds + RING_OFF, S);
    }
    SEAM(1);
    if (IN(2)) {
        if (F.G == 256) {
            const int xcd = F.vcu >> 5, wi = F.vcu & 31, b = xcd >> 1, half = xcd & 1;
#define IDX_GRP_A(k) (b * 1024 + (127 - (((k) * 64 + half * 32 + wi) >> 3)) * 8 + (((k) * 64 + half * 32 + wi) & 7))
            IdxPre P; idx_prefetch(F, IDX_GRP_A(0), P);
            for (int k = 0; k < 16; ++k) indexer_group(F, IDX_GRP_A(k), IDX_GRP_A(k < 15 ? k + 1 : k), P);
#undef IDX_GRP_A
        } else {
#define IDX_GRP_B(i) (((i) & 31) >> 3) * 1024 + (127 - ((i) >> 5)) * 8 + ((i) & 7)
            if (F.vcu < 4096) { IdxPre P; idx_prefetch(F, IDX_GRP_B(F.vcu), P);
                for (int i = F.vcu; i < 4096; i += F.G) indexer_group(F, IDX_GRP_B(i), IDX_GRP_B(i + F.G < 4096 ? i + F.G : i), P); }
#undef IDX_GRP_B
        }
        __syncthreads();
        if (F.vcu < 2048) { KvIn kin; ret_kv_load(F, F.vcu, kin);
            for (int it = F.vcu; it < 2048; it += F.G) ret_kv_item(F, it, kin, it + F.G < 2048 ? it + F.G : -1); }
        __syncthreads();
    }
    SEAM(2);
    if (IN(3)) { ret_scan(F); }
    SEAM(3);
    if (IN(4)) {
        if (F.tid < 64) { const int e = F.tid >> 2, j = F.tid & 3; ((LAS float*)(F.lds + attn_body::LDS_TBL))[F.tid] = ((e >> j) & 1) ? 0.f : -INFINITY; }
        __syncthreads();
        const attn_body::bf16* Qp = (const attn_body::bf16*)(F.ws + WS_DQ); const attn_body::bf16* Kp = (const attn_body::bf16*)(F.ws + WS_DK); const attn_body::bf16* Vp = (const attn_body::bf16*)(F.ws + WS_DV);
        attn_body::bf16* Op = (attn_body::bf16*)(F.ws + WS_YDSA);
        const unsigned long long* BMp = (const unsigned long long*)((unsigned char*)F.out + OUT_BM);
        for (int v = F.vcu; v < 256; v += F.G) {
            const int s = v & 7, bh = v >> 3;
#pragma unroll 1
            for (int i = 0; i < 4; ++i) { const int qb = (i == 0) ? s : (i == 1) ? 15 - s : (i == 2) ? 16 + s : 31 - s;
                attn_body::attn_unit<8>(bh >> 3, bh & 7, qb, Qp, Kp, Vp, Op, BMp, (char*)lds + RING_OFF); }
        }
        __syncthreads();
        if (F.vcu < 2048) { OutIn oin; ret_out_load(F, F.vcu, oin);
            for (int it = F.vcu; it < 2048; it += F.G) ret_out_item(F, it, oin, it + F.G < 2048 ? it + F.G : -1); }
        __syncthreads();
    }
    SEAM(4);
    if (IN(5)) {
        pg8::Desc S{}; S.A0 = (const u16*)(F.ws + WS_YRET); S.B0 = (const u16*)(F.ws + WS_WRO); S.A1 = (const u16*)(F.ws + WS_YDSA); S.B1 = (const u16*)(F.ws + WS_WDO);
        S.K = 512; S.nM = NTOK / 256; S.nN = 4; S.nsub = 2; S.G = F.G; S.c = (int)blockIdx.x; S.mode = pg8::M_MERGE; S.ws = F.ws; S.xin = nullptr; S.out = nullptr;
        pg8::gemm_phase(F.lds + RING_OFF, S);
    }
    SEAM(5);
    if (IN(6)) {
        pg8::Desc S{}; S.A0 = (const u16*)(F.ws + WS_MERGED); S.B0 = (const u16*)(F.ws + WS_WOUT); S.A1 = S.A0; S.B1 = S.B0;
        S.K = 1024; S.nM = NTOK / 256; S.nN = 4; S.nsub = 1; S.G = F.G; S.c = (int)blockIdx.x; S.mode = pg8::M_OUT; S.ws = F.ws; S.xin = F.in[0]; S.out = F.out;
        pg8::gemm_phase(F.lds + RING_OFF, S);
    }
    SEAM(6);
    if (IN(7)) {
        pg8::Desc S{}; S.A0 = (const u16*)(F.ws + WS_X1B); S.B0 = (const u16*)(F.ws + WS_WSC); S.A1 = S.A0; S.B1 = S.B0;
        S.K = 1024; S.nM = NTOK / 256; S.nN = 8; S.nsub = 1; S.G = F.G; S.c = (int)blockIdx.x; S.mode = pg8::M_SCORE; S.ws = F.ws; S.xin = nullptr; S.out = nullptr;
        pg8::gemm_phase(F.lds + RING_OFF, S);
    }
    SEAM(7);
    if (IN(8)) {
        LAS float* wsc = (LAS float*)(F.lds + F.wave * PEER_WSC);
        const int gw = F.vcu * NWAVES + F.wave, NGW = F.G * NWAVES;
        if (N_LAUNCHES == 1 && NGW <= NTOK / PEER_T) {
            unsigned* q = ctl + CW_PQ;
            int g = gw;
            while (g < NTOK / PEER_T) { const unsigned tk = peer_group(F, g, wsc, q); g = NGW + (int)tk; }
        } else {
            for (int g = gw; g < NTOK / PEER_T; g += NGW) (void)peer_group(F, g, wsc, nullptr);
        }
    }
#undef IN
#undef SEAM
}

extern "C" void kernel_launch(void* const* d_in, const int* in_sizes, int n_in, void* d_out, int out_size, void* d_ws, size_t ws_size, hipStream_t stream) {
    static int grid = 0;
    if (grid == 0) {
        if (n_in != 13 || in_sizes[0] != NTOK * DMODEL || out_size != NTOK * DMODEL || ws_size < WS_END) {
            fprintf(stderr, "kernel_launch: unexpected shapes (n_in %d, in0 %d, out %d, ws %zu)\n", n_in, n_in > 0 ? in_sizes[0] : -1, out_size, ws_size); grid = -1; return; }
        int dev = 0, cus = 0, per_cu = 0;
        if (hipGetDevice(&dev) != hipSuccess || hipDeviceGetAttribute(&cus, hipDeviceAttributeMultiprocessorCount, dev) != hipSuccess) { grid = -1; return; }
        if (hipFuncSetAttribute((const void*)mk_fwd, hipFuncAttributeMaxDynamicSharedMemorySize, LDS_BYTES) != hipSuccess) { fprintf(stderr, "kernel_launch: hipFuncSetAttribute failed\n"); grid = -1; return; }
        if (hipOccupancyMaxActiveBlocksPerMultiprocessor(&per_cu, (const void*)mk_fwd, NWAVES * 64, LDS_BYTES) != hipSuccess || per_cu < 1) {
            fprintf(stderr, "kernel_launch: occupancy query reports %d workgroups per CU\n", per_cu); }
        (void)hipGetLastError();
        grid = cus;
    }
    if (grid < 0) return;
    if (hipMemsetAsync((char*)d_ws + WS_CTL, 0, CTL_ZERO_BYTES, stream) != hipSuccess) return;
    Args a{};
    for (int i = 0; i < 13; ++i) a.in[i] = (const float*)d_in[i];
    a.out = (float*)d_out; a.ws = (unsigned char*)d_ws;
    for (int li = 0; li < N_LAUNCHES; ++li) {
        a.ph_lo = (N_LAUNCHES == 1) ? 0 : li; a.ph_hi = (N_LAUNCHES == 1) ? N_PHASES : li + 1; a.li = li; a.pad = 0;
        hipLaunchKernelGGL(mk_fwd, dim3(grid), dim3(NWAVES * 64), LDS_BYTES, stream, a);
    }
}
```

```cpp
#include <hip/hip_runtime.h>
#include <hip/hip_bf16.h>
#include <cstdio>
#include <cstdint>
#include <cmath>

#define LAS __attribute__((address_space(3)))
#define GAS __attribute__((address_space(1)))
typedef unsigned short u16;
typedef short bf16x8 __attribute__((ext_vector_type(8)));
typedef _Float16 f16x8 __attribute__((ext_vector_type(8)));
typedef _Float16 f16x4 __attribute__((ext_vector_type(4)));
typedef float f32x2 __attribute__((ext_vector_type(2)));
typedef float f32x4 __attribute__((ext_vector_type(4)));
typedef float f32x16 __attribute__((ext_vector_type(16)));
typedef unsigned u32x2 __attribute__((ext_vector_type(2)));
typedef unsigned u32x4 __attribute__((ext_vector_type(4)));
typedef short s16x4 __attribute__((ext_vector_type(4)));
typedef unsigned short u16x2 __attribute__((ext_vector_type(2)));
typedef __bf16 bf16x2v __attribute__((ext_vector_type(2)));

constexpr int NTOK = 32768, SEQ = 8192, NBATCH = 4, DMODEL = 1024;
constexpr int D_IN = 5444;
constexpr int N1PAD = 5632;
constexpr float EPS = 1e-6f;
constexpr float C2 = 0.125f * 1.4426950408889634f;
constexpr int NWAVES = 8;

constexpr size_t MiB = 1u << 20;
constexpr size_t WS_CTL = 0, CTL_ZERO_BYTES = 32768;
constexpr size_t WS_WIN = 1 * MiB;
constexpr size_t WS_WRO = 12 * MiB;
constexpr size_t WS_WDO = 13 * MiB;
constexpr size_t WS_WOUT = 14 * MiB;
constexpr size_t WS_WSC = 16 * MiB;
constexpr size_t WS_U = 20 * MiB;
constexpr size_t WS_V = 52 * MiB;
constexpr size_t WS_TABA = 84 * MiB;
constexpr size_t WS_TABB = 86 * MiB;
constexpr size_t WS_IW = 87 * MiB;
constexpr size_t WS_KUV = 87 * MiB + 768 * 1024;
constexpr size_t WS_RSTD = 87 * MiB + 896 * 1024;
constexpr size_t WS_XB = 428 * MiB;
constexpr size_t WS_YRET = 88 * MiB;
constexpr size_t WS_YDSA = 120 * MiB;
constexpr size_t WS_RQ = 152 * MiB;
constexpr size_t WS_RK = 168 * MiB;
constexpr size_t WS_RV = 184 * MiB;
constexpr size_t WS_RG = 216 * MiB;
constexpr size_t WS_DQ = 248 * MiB;
constexpr size_t WS_DK = 280 * MiB;
constexpr size_t WS_DV = 312 * MiB;
constexpr size_t WS_IQ = 344 * MiB;
constexpr size_t WS_IK = 360 * MiB;
constexpr size_t WS_GATES = 364 * MiB;
constexpr size_t WS_MERGED = 152 * MiB;
constexpr size_t WS_X1B = 216 * MiB;
constexpr size_t WS_SC = 364 * MiB;
constexpr size_t WS_END = 492 * MiB;
constexpr size_t OUT_KV = 0, OUT_BM = 64 * MiB;

#define RLX_AGENT __ATOMIC_RELAXED, __HIP_MEMORY_SCOPE_AGENT
#define LDS_WAIT() asm volatile("s_waitcnt lgkmcnt(0)" ::: "memory")
#define VM_WAIT() asm volatile("s_waitcnt vmcnt(0)" ::: "memory")
__device__ __forceinline__ unsigned cvt_pk_bf16(float lo, float hi) { unsigned r; asm volatile("v_cvt_pk_bf16_f32 %0, %1, %2" : "=v"(r) : "v"(lo), "v"(hi)); return r; }
__device__ __forceinline__ unsigned f2bf(float f) { unsigned u = __builtin_bit_cast(unsigned, f); return (u + 0x7fffu + ((u >> 16) & 1u)) >> 16; }
__device__ __forceinline__ float bf2f(unsigned b) { return __builtin_bit_cast(float, b << 16); }
__device__ __forceinline__ unsigned pk_f16(float lo, float hi) { _Float16 a = (_Float16)lo, b = (_Float16)hi; return (unsigned)__builtin_bit_cast(u16, a) | ((unsigned)__builtin_bit_cast(u16, b) << 16); }
template <int CTRL> __device__ __forceinline__ int dppi(int x) { return __builtin_amdgcn_mov_dpp(x, CTRL, 0xf, 0xf, true); }
template <int CTRL> __device__ __forceinline__ float dppf(float x) { return __builtin_bit_cast(float, __builtin_amdgcn_mov_dpp(__builtin_bit_cast(int, x), CTRL, 0xf, 0xf, true)); }
__device__ __forceinline__ float row16_sum(float v) { v += dppf<0xB1>(v); v += dppf<0x4E>(v); v += dppf<0x141>(v); v += dppf<0x128>(v); return v; }
__device__ __forceinline__ float row16_max(float v) { v = fmaxf(v, dppf<0xB1>(v)); v = fmaxf(v, dppf<0x4E>(v)); v = fmaxf(v, dppf<0x141>(v)); v = fmaxf(v, dppf<0x128>(v)); return v; }
__device__ __forceinline__ unsigned row16_maxu(unsigned v) {
    unsigned t;
    t = (unsigned)dppi<0xB1>((int)v); v = v > t ? v : t; t = (unsigned)dppi<0x4E>((int)v); v = v > t ? v : t;
    t = (unsigned)dppi<0x141>((int)v); v = v > t ? v : t; t = (unsigned)dppi<0x128>((int)v); v = v > t ? v : t; return v; }
__device__ __forceinline__ float wave_sum(float v) {
    v = row16_sum(v);
    { auto r = __builtin_amdgcn_permlane16_swap(__float_as_uint(v), __float_as_uint(v), false, false); const unsigned r0 = r[0], r1 = r[1]; v = __uint_as_float(r0) + __uint_as_float(r1); }
    { auto r = __builtin_amdgcn_permlane32_swap(__float_as_uint(v), __float_as_uint(v), false, false); const unsigned r0 = r[0], r1 = r[1]; v = __uint_as_float(r0) + __uint_as_float(r1); }
    return v; }
__device__ __forceinline__ int wave_sum_i(int v) {
    v += dppi<0xB1>(v); v += dppi<0x4E>(v); v += dppi<0x141>(v); v += dppi<0x128>(v);
    { auto r = __builtin_amdgcn_permlane16_swap((unsigned)v, (unsigned)v, false, false); const unsigned r0 = r[0], r1 = r[1]; v = (int)(r0 + r1); }
    { auto r = __builtin_amdgcn_permlane32_swap((unsigned)v, (unsigned)v, false, false); const unsigned r0 = r[0], r1 = r[1]; v = (int)(r0 + r1); }
    return v; }
__device__ __forceinline__ float wave_max(float v) {
    v = row16_max(v);
    { auto r = __builtin_amdgcn_permlane16_swap(__float_as_uint(v), __float_as_uint(v), false, false); const unsigned r0 = r[0], r1 = r[1]; v = fmaxf(__uint_as_float(r0), __uint_as_float(r1)); }
    { auto r = __builtin_amdgcn_permlane32_swap(__float_as_uint(v), __float_as_uint(v), false, false); const unsigned r0 = r[0], r1 = r[1]; v = fmaxf(__uint_as_float(r0), __uint_as_float(r1)); }
    return v; }
struct __attribute__((packed, aligned(4))) U3 { unsigned x, y, z; };
__device__ __forceinline__ unsigned fp6_code(float x) {
    const float a = fabsf(x);
    const unsigned bits = __float_as_uint(a);
    const unsigned rn = (bits + 0x7FFFFu + ((bits >> 20) & 1u)) >> 20;
    const int cn = (int)rn - 1008;
    const int cs = (int)__builtin_rintf(a * 8.0f);
    int c = a >= 1.0f ? cn : cs; c = c > 31 ? 31 : c;
    return (unsigned)c | (x < 0.f ? 32u : 0u);
}
__device__ __forceinline__ float sigmoidf_(float x) { return __builtin_amdgcn_rcpf(1.0f + __builtin_amdgcn_exp2f(-1.4426950408889634f * x)); }
__device__ __forceinline__ float gelu_erf(float v) {
    const float av = fabsf(v), t = __builtin_amdgcn_rcpf(av * 0.2316418882f + 1.0f);
    float q = t * 0.5307027145f + (-0.7265760135f); q = q * t + 0.7107068705f; q = q * t + (-0.142248368f); q = q * t + 0.127414796f; q = q * t;
    const float e = __builtin_amdgcn_exp2f((v * v) * (-0.72134752044f));
    const float m = v * (q * e);
    return v < 0.f ? m : v - m;
}

namespace pg8 {
typedef u16 bf16_t;
constexpr int BM = 256, BK = 64, HALF = 128, HTB = HALF * BK * 2, STAGE_BYTES = 8 * HTB, NXCD = 8, WGM = 8;
__host__ __device__ __forceinline__ int lds_byte(int r, int c) { const int st = (r >> 4) * 2 + (c >> 5), rr = r & 15, cc = c & 31, ob = rr * 64 + cc * 2; return st * 1024 + (ob ^ (((ob >> 9) & 1) << 5)); }
__host__ __device__ __forceinline__ void stage_rc(int b, int& R, int& C) { const int st = b / 1024, sb = b % 1024, swz = sb ^ (((sb >> 9) & 1) << 5); R = (st >> 1) * 16 + swz / 64; C = (st & 1) * 32 + (swz % 64) / 2; }
__host__ __device__ __forceinline__ int perm32(int rho) { const int n = rho >> 4, i = rho & 15; return 8 * (i >> 2) + 4 * n + (i & 3); }
struct Unit { int pm, pn, sub; };
enum Mode { M_PROJ = 0, M_MERGE = 1, M_OUT = 2, M_SCORE = 3 };
struct Desc {
    const bf16_t* A0; const bf16_t* B0; const bf16_t* A1; const bf16_t* B1;
    int K, nM, nN, nsub, G, c, mode;
    unsigned char* ws; const float* xin; float* out;
    __device__ __forceinline__ bool next(int i, Unit& u) const {
        const int ii = (nsub == 2) ? (i >> 1) : i; u.sub = (nsub == 2) ? (i & 1) : 0;
        const int nwg = nM * nN; const long L = (long)ii * G + c; if (L >= nwg) return false;
        int wgid = (int)L; { const int q = nwg / NXCD, r = nwg % NXCD, xcd = wgid % NXCD, off = wgid / NXCD; wgid = (xcd < r ? xcd * (q + 1) : r * (q + 1) + (xcd - r) * q) + off; }
        const int nig = WGM * nN, gid = wgid / nig, fm = gid * WGM, gsz = (nM - fm) < WGM ? (nM - fm) : WGM;
        u.pm = fm + ((wgid % nig) % gsz); u.pn = (wgid % nig) / gsz; return true;
    }
};

__device__ __forceinline__ u32x4 pack8_bf16(const f32x4 a, const f32x4 b) { u32x4 w; w.x = cvt_pk_bf16(a[0], a[1]); w.y = cvt_pk_bf16(a[2], a[3]); w.z = cvt_pk_bf16(b[0], b[1]); w.w = cvt_pk_bf16(b[2], b[3]); return w; }
__device__ __forceinline__ u32x4 pack8_f16(const f32x4 a, const f32x4 b) { u32x4 w; w.x = pk_f16(a[0], a[1]); w.y = pk_f16(a[2], a[3]); w.z = pk_f16(b[0], b[1]); w.w = pk_f16(b[2], b[3]); return w; }

__device__ __forceinline__ void epi_proj(const f32x4 (&acc)[2][2][4][2], const Unit& u, int wr, int wc, int fr, int fq, unsigned char* ws) {
    const int pn = u.pn;
    const int row0 = u.pm * BM + wr * 64 + fr;
    if (pn <= 1) {
        bf16_t* O = (bf16_t*)(ws + (pn == 0 ? WS_RQ : WS_RK)); const float sc = pn == 0 ? 0.125f : 1.0f;
        const f32x2* tab = (const f32x2*)(ws + WS_TABA);
#pragma unroll
        for (int ai = 0; ai < 2; ++ai)
#pragma unroll
            for (int m = 0; m < 4; ++m) {
                const int row = row0 + ai * HALF + m * 16; const int pos = row & (SEQ - 1);
                const f32x4* tp = (const f32x4*)(tab + pos * 32 + 8 * fq);
                const f32x4 t0 = tp[0], t1 = tp[1], t2 = tp[2], t3 = tp[3];
                const float cs[8] = {t0[0], t0[2], t1[0], t1[2], t2[0], t2[2], t3[0], t3[2]}, sn[8] = {t0[1], t0[3], t1[1], t1[3], t2[1], t2[3], t3[1], t3[3]};
                f32x4 o1a, o1b, o2a, o2b;
#pragma unroll
                for (int j = 0; j < 4; ++j) {
                    const float a0 = acc[ai][0][m][0][j], b0 = acc[ai][1][m][0][j], a1 = acc[ai][0][m][1][j], b1 = acc[ai][1][m][1][j];
                    o1a[j] = (a0 * cs[j] - b0 * sn[j]) * sc; o2a[j] = (a0 * sn[j] + b0 * cs[j]) * sc;
                    o1b[j] = (a1 * cs[4 + j] - b1 * sn[4 + j]) * sc; o2b[j] = (a1 * sn[4 + j] + b1 * cs[4 + j]) * sc; }
                bf16_t* rp = O + (size_t)row * 256 + wc * 64 + 8 * fq;
                *(u32x4*)rp = pack8_bf16(o1a, o1b); *(u32x4*)(rp + 32) = pack8_bf16(o2a, o2b);
            }
        return;
    }
    if (pn >= 14) {
        unsigned char* G8 = ws + WS_GATES;
#pragma unroll
        for (int ai = 0; ai < 2; ++ai)
#pragma unroll
            for (int m = 0; m < 4; ++m) { unsigned w[4];
#pragma unroll
                for (int bj = 0; bj < 2; ++bj)
#pragma unroll
                    for (int n = 0; n < 2; ++n) { unsigned pk = 0u;
#pragma unroll
                        for (int j = 0; j < 4; ++j) pk = __builtin_amdgcn_cvt_pk_u8_f32(255.0f * sigmoidf_(acc[ai][bj][m][n][j]), j, pk);
                        w[2 * bj + n] = pk; }
                *(u32x4*)(G8 + (size_t)(row0 + ai * HALF + m * 16) * 2048 + (pn - 14) * 256 + wc * 64 + fq * 16) = (u32x4){w[0], w[1], w[2], w[3]}; }
        return;
    }
    if (pn == 2 || pn == 3 || pn == 10 || pn == 11 || pn == 4 || pn == 5) {
        bf16_t* O; int ldc, colt; int act = 0;
        if (pn <= 3) { O = (bf16_t*)(ws + WS_RV); ldc = 512; colt = (pn - 2) * 256; }
        else if (pn <= 5) { O = (bf16_t*)(ws + WS_RG); ldc = 512; colt = (pn - 4) * 256; act = 1; }
        else { O = (bf16_t*)(ws + WS_DV); ldc = 512; colt = (pn - 10) * 256; }
        const int col0 = colt + wc * 32 + 8 * fq;
#pragma unroll
        for (int ai = 0; ai < 2; ++ai)
#pragma unroll
            for (int m = 0; m < 4; ++m) { bf16_t* rowp = O + (size_t)(row0 + ai * HALF + m * 16) * ldc + col0;
#pragma unroll
                for (int bj = 0; bj < 2; ++bj) { f32x4 v0 = acc[ai][bj][m][0], v1 = acc[ai][bj][m][1];
                    if (act == 1) {
#pragma unroll
                        for (int j = 0; j < 4; ++j) { v0[j] = v0[j] * sigmoidf_(v0[j]); v1[j] = v1[j] * sigmoidf_(v1[j]); } }
                    *(u32x4*)(rowp + bj * HALF) = pack8_bf16(v0, v1); } }
        return;
    }
    if (pn == 13) {
        _Float16* OK = (_Float16*)(ws + WS_IK); float* OW = (float*)(ws + WS_IW);
        const f32x2* tab = (const f32x2*)(ws + WS_TABB);
        if (wc > 2) return;
#pragma unroll
        for (int ai = 0; ai < 2; ++ai)
#pragma unroll
            for (int m = 0; m < 4; ++m) {
                const int row = row0 + ai * HALF + m * 16; const int pos = row & (SEQ - 1);
                f32x4 v0 = acc[ai][0][m][0], v1 = acc[ai][0][m][1];
                if (wc == 2) { if (fq == 0) { *(f32x4*)(OW + (size_t)row * 4) = v0 * 0.0625f; } continue; }
                _Float16* tp_ = OK + (size_t)(row >> 5) * 2048 + (row & 31) * 8;
                if (wc == 0 && fq < 2) {
                    const f32x4* tp = (const f32x4*)(tab + pos * 8 + 4 * fq); const f32x4 t0 = tp[0], t1 = tp[1];
                    const float cs[4] = {t0[0], t0[2], t1[0], t1[2]}, sn[4] = {t0[1], t0[3], t1[1], t1[3]};
                    f32x4 o1, o2;
#pragma unroll
                    for (int j = 0; j < 4; ++j) { o1[j] = v0[j] * cs[j] - v1[j] * sn[j]; o2[j] = v0[j] * sn[j] + v1[j] * cs[j]; }
                    u32x2 w1, w2; w1.x = pk_f16(o1[0], o1[1]); w1.y = pk_f16(o1[2], o1[3]); w2.x = pk_f16(o2[0], o2[1]); w2.y = pk_f16(o2[2], o2[3]);
                    *(u32x2*)(tp_ + 4 * fq) = w1; *(u32x2*)(tp_ + 256 + 4 * fq) = w2;
                } else { const int c = 4 * wc + fq; *(u32x4*)(tp_ + (c >> 1) * 512 + (c & 1) * 256) = pack8_f16(v0, v1); }
            }
        return;
    }
    {
        const bool f16o = (pn == 12);
        bf16_t* O; int ldc, colt; float sc = 1.0f;
        if (pn <= 7) { O = (bf16_t*)(ws + WS_DQ); ldc = 512; colt = (pn - 6) * 256; sc = C2; }
        else if (pn <= 9) { O = (bf16_t*)(ws + WS_DK); ldc = 512; colt = (pn - 8) * 256; }
        else { O = (bf16_t*)(ws + WS_IQ); ldc = 256; colt = 0; }
        const f32x2* tab = (const f32x2*)(ws + WS_TABB);
        const bool rot = ((wc & 1) == 0) && (fq < 2);
#pragma unroll
        for (int ai = 0; ai < 2; ++ai)
#pragma unroll
            for (int m = 0; m < 4; ++m) {
                const int row = row0 + ai * HALF + m * 16; const int pos = row & (SEQ - 1);
                f32x4 t0 = {1.f, 0.f, 1.f, 0.f}, t1 = {1.f, 0.f, 1.f, 0.f};
                if (rot) { const f32x4* tp = (const f32x4*)(tab + pos * 8 + 4 * fq); t0 = tp[0]; t1 = tp[1]; }
                const float cs[4] = {t0[0], t0[2], t1[0], t1[2]}, sn[4] = {t0[1], t0[3], t1[1], t1[3]};
#pragma unroll
                for (int bj = 0; bj < 2; ++bj) {
                    f32x4 v0 = acc[ai][bj][m][0] * sc, v1 = acc[ai][bj][m][1] * sc;
                    bf16_t* rp = O + (size_t)row * ldc + colt + bj * HALF + wc * 32;
                    if (rot) {
                        f32x4 o1, o2;
#pragma unroll
                        for (int j = 0; j < 4; ++j) { o1[j] = v0[j] * cs[j] - v1[j] * sn[j]; o2[j] = v0[j] * sn[j] + v1[j] * cs[j]; }
                        u32x2 w1, w2;
                        if (f16o) { w1.x = pk_f16(o1[0], o1[1]); w1.y = pk_f16(o1[2], o1[3]); w2.x = pk_f16(o2[0], o2[1]); w2.y = pk_f16(o2[2], o2[3]); }
                        else { w1.x = cvt_pk_bf16(o1[0], o1[1]); w1.y = cvt_pk_bf16(o1[2], o1[3]); w2.x = cvt_pk_bf16(o2[0], o2[1]); w2.y = cvt_pk_bf16(o2[2], o2[3]); }
                        *(u32x2*)(rp + 4 * fq) = w1; *(u32x2*)(rp + 8 + 4 * fq) = w2;
                    } else { *(u32x4*)(rp + 8 * fq) = f16o ? pack8_f16(v0, v1) : pack8_bf16(v0, v1); }
                }
            }
    }
}
__device__ __forceinline__ void epi_merge(f32x4 (&acc)[2][2][4][2], const Unit& u, int wr, int wc, int fr, int fq, unsigned char* ws) {
    const unsigned char* G8 = ws + WS_GATES; bf16_t* O = (bf16_t*)(ws + WS_MERGED);
    const int row0 = u.pm * BM + wr * 64 + fr, col0 = u.pn * BM + wc * 32 + 8 * fq;
    const int goff = wc * 64 + fq * 16;
    constexpr float K = 1.0f / 255.0f;
#pragma unroll
    for (int ai = 0; ai < 2; ++ai)
#pragma unroll
        for (int m = 0; m < 4; ++m) { const size_t row = (size_t)(row0 + ai * HALF + m * 16);
            const u32x4 gd = *(const u32x4*)(G8 + row * 2048 + (4 + u.pn) * 256 + goff);
            const unsigned gdw[4] = {gd.x, gd.y, gd.z, gd.w};
            if (u.sub == 0) {
                const u32x4 gr = *(const u32x4*)(G8 + row * 2048 + u.pn * 256 + goff);
                const unsigned grw[4] = {gr.x, gr.y, gr.z, gr.w};
#pragma unroll
                for (int bj = 0; bj < 2; ++bj)
#pragma unroll
                    for (int n = 0; n < 2; ++n)
#pragma unroll
                        for (int j = 0; j < 4; ++j) { const float d = (float)((gdw[2 * bj + n] >> (8 * j)) & 0xffu) * K, r = (float)((grw[2 * bj + n] >> (8 * j)) & 0xffu) * K;
                            acc[ai][bj][m][n][j] *= r * __builtin_amdgcn_rcpf(fmaxf(d, 1e-20f)); }
            } else {
#pragma unroll
                for (int bj = 0; bj < 2; ++bj) { f32x4 v0, v1;
#pragma unroll
                    for (int j = 0; j < 4; ++j) { v0[j] = acc[ai][bj][m][0][j] * fmaxf((float)((gdw[2 * bj] >> (8 * j)) & 0xffu) * K, 1e-20f); v1[j] = acc[ai][bj][m][1][j] * fmaxf((float)((gdw[2 * bj + 1] >> (8 * j)) & 0xffu) * K, 1e-20f); }
                    *(u32x4*)(O + row * 1024 + col0 + bj * HALF) = pack8_bf16(v0, v1); }
            } }
}
__device__ __forceinline__ void epi_out(const f32x4 (&acc)[2][2][4][2], const Unit& u, int wr, int wc, int fr, int fq, unsigned char* ws, const float* xin, float* out) {
    bf16_t* XB = (bf16_t*)(ws + WS_X1B); const bf16_t* XR = (const bf16_t*)(ws + WS_XB); (void)out; (void)xin;
    const int row0 = u.pm * BM + wr * 64 + fr, col0 = u.pn * BM + wc * 32 + 8 * fq;
#pragma unroll
    for (int ai = 0; ai < 2; ++ai)
#pragma unroll
        for (int m = 0; m < 4; ++m) { const size_t off = (size_t)(row0 + ai * HALF + m * 16) * 1024 + col0;
#pragma unroll
            for (int bj = 0; bj < 2; ++bj) { const u32x4 xr = *(const u32x4*)(XR + off + bj * HALF);
                const f32x4 x0 = {bf2f(xr.x & 0xffffu), bf2f(xr.x >> 16), bf2f(xr.y & 0xffffu), bf2f(xr.y >> 16)}, x1 = {bf2f(xr.z & 0xffffu), bf2f(xr.z >> 16), bf2f(xr.w & 0xffffu), bf2f(xr.w >> 16)};
                *(u32x4*)(XB + off + bj * HALF) = pack8_bf16(x0 + acc[ai][bj][m][0], x1 + acc[ai][bj][m][1]); } }
}
__device__ __forceinline__ void epi_score(const f32x4 (&acc)[2][2][4][2], const Unit& u, int wr, int wc, int fr, int fq, unsigned char* ws) {
    _Float16* O = (_Float16*)(ws + WS_SC);
    const int row0 = u.pm * BM + wr * 64 + fr, col0 = u.pn * BM + wc * 32 + 8 * fq;
#pragma unroll
    for (int ai = 0; ai < 2; ++ai)
#pragma unroll
        for (int m = 0; m < 4; ++m) { _Float16* rowp = O + (size_t)(row0 + ai * HALF + m * 16) * 2048 + col0;
#pragma unroll
            for (int bj = 0; bj < 2; ++bj) *(u32x4*)(rowp + bj * HALF) = pack8_f16(acc[ai][bj][m][0], acc[ai][bj][m][1]); }
}

__device__ __forceinline__ void gemm_phase(LAS unsigned char* lds, const Desc& S) {
    const int tid = threadIdx.x, wid = __builtin_amdgcn_readfirstlane(tid >> 6), lane = tid & 63, wr = wid >> 2, wc = wid & 3, fr = lane & 15, fq = lane >> 4;
    const int K = S.K, nt = K / BK;
    const bool PERM = true;
    unsigned voffA[2], voffB[2];
#pragma unroll
    for (int i = 0; i < 2; ++i) { int R, C; stage_rc(tid * 16 + i * 8192, R, C); const int Rb = PERM ? ((R & ~31) + perm32(R & 31)) : R;
        voffA[i] = (unsigned)(R * K + C) * 2u; voffB[i] = (unsigned)(Rb * K + C) * 2u; }
    const size_t kstep = (size_t)(BK * 2);
    const size_t hstep = (size_t)HALF * K * 2;
    const size_t tstep = 2 * hstep;
    const unsigned ldsw = (unsigned)wid * 1024u;
    const int aoff = lds_byte(wr * 64 + fr, fq * 8), boff = lds_byte(wc * 32 + fr, fq * 8);
#define PG8_SA(b, h) (((b) * 2 + (h)) * HTB)
#define PG8_SB(b, h) ((4 + (b) * 2 + (h)) * HTB)
#define PG8_STAGE(bufoff, gbase, voff) do { _Pragma("unroll") for (int _i = 0; _i < 2; ++_i) \
        __builtin_amdgcn_global_load_lds((const unsigned*)((const char*)(gbase) + (voff)[_i]), (LAS unsigned*)(lds + (bufoff) + ldsw + _i * 8192), 16, 0, 0); } while (0)
#define PG8_LDA(dst, b, h) do { _Pragma("unroll") for (int m = 0; m < 4; ++m) _Pragma("unroll") for (int k = 0; k < 2; ++k) dst[m][k] = *(const LAS bf16x8*)(lds + PG8_SA(b, h) + aoff + m * 2048 + k * 1024); } while (0)
#define PG8_LDB(dst, b, h) do { _Pragma("unroll") for (int n = 0; n < 2; ++n) _Pragma("unroll") for (int k = 0; k < 2; ++k) dst[n][k] = *(const LAS bf16x8*)(lds + PG8_SB(b, h) + boff + n * 2048 + k * 1024); } while (0)
#define PG8_MMA(ai, bj, At, Bt) do { __builtin_amdgcn_s_setprio(1); _Pragma("unroll") for (int m = 0; m < 4; ++m) _Pragma("unroll") for (int n = 0; n < 2; ++n) _Pragma("unroll") for (int k = 0; k < 2; ++k) \
        acc[ai][bj][m][n] = __builtin_amdgcn_mfma_f32_16x16x32_bf16(Bt[n][k], At[m][k], acc[ai][bj][m][n], 0, 0, 0); __builtin_amdgcn_s_setprio(0); } while (0)
#define PG8_WAIT_V(n) asm volatile("s_waitcnt vmcnt(" #n ")" ::: "memory")
#define PG8_WAIT_L(n) asm volatile("s_waitcnt lgkmcnt(" #n ")" ::: "memory")
#define PG8_BAR __builtin_amdgcn_s_barrier()
#define PG8_SCHED __builtin_amdgcn_sched_barrier(0)
#define PG8_UA(u) ((const char*)((u).sub ? S.A1 : S.A0) + (size_t)(u).pm * tstep)
#define PG8_UB(u) ((const char*)((u).sub ? S.B1 : S.B0) + (size_t)(u).pn * tstep)
    Unit cur, nxt; int ui = 0;
    if (!S.next(0, cur)) return;
    f32x4 acc[2][2][4][2];
#pragma unroll
    for (int a = 0; a < 2; ++a)
#pragma unroll
        for (int b = 0; b < 2; ++b)
#pragma unroll
            for (int m = 0; m < 4; ++m)
#pragma unroll
                for (int n = 0; n < 2; ++n) acc[a][b][m][n] = (f32x4){0.f, 0.f, 0.f, 0.f};
    bf16x8 At[4][2], B0[2][2], B1[2][2];
    const char* cA = PG8_UA(cur); const char* cB = PG8_UB(cur);
    PG8_STAGE(PG8_SB(0, 0), cB, voffB); PG8_STAGE(PG8_SB(0, 1), cB + hstep, voffB); PG8_STAGE(PG8_SA(0, 0), cA, voffA); PG8_STAGE(PG8_SA(0, 1), cA + hstep, voffA);
    if (wr == 1) PG8_BAR;
    PG8_WAIT_V(2); PG8_BAR;
    PG8_STAGE(PG8_SB(1, 0), cB + kstep, voffB); PG8_STAGE(PG8_SA(1, 0), cA + kstep, voffA); PG8_STAGE(PG8_SB(1, 1), cB + hstep + kstep, voffB);
    PG8_WAIT_V(6); PG8_BAR;
    for (;;) {
        const bool has_next = S.next(ui + 1, nxt);
        const char* nA = has_next ? PG8_UA(nxt) : cA; const char* nB = has_next ? PG8_UB(nxt) : cB;
        for (int t = 0; t < nt; t += 2) {
            const bool last = (t == nt - 2);
            const char* a1 = cA + (size_t)(t + 1) * kstep;
            const char* a2 = last ? nA : cA + (size_t)(t + 2) * kstep; const char* b2 = last ? nB : cB + (size_t)(t + 2) * kstep;
            const char* a3 = a2 + kstep; const char* b3 = b2 + kstep;
            PG8_LDB(B0, 0, 0); PG8_LDB(B1, 0, 1); PG8_SCHED; PG8_LDA(At, 0, 0); PG8_STAGE(PG8_SA(1, 1), a1 + hstep, voffA);
            PG8_WAIT_V(8); PG8_WAIT_L(0); PG8_BAR; PG8_MMA(0, 0, At, B0); PG8_MMA(0, 1, At, B1); PG8_BAR; PG8_SCHED;
            PG8_LDA(At, 0, 1); PG8_STAGE(PG8_SB(0, 0), b2, voffB); PG8_STAGE(PG8_SB(0, 1), b2 + hstep, voffB); PG8_STAGE(PG8_SA(0, 0), a2, voffA);
            PG8_WAIT_V(8); PG8_WAIT_L(0); PG8_BAR; PG8_MMA(1, 0, At, B0); PG8_MMA(1, 1, At, B1); PG8_BAR; PG8_SCHED;
            PG8_LDB(B0, 1, 0); PG8_LDB(B1, 1, 1); PG8_SCHED; PG8_LDA(At, 1, 0); PG8_STAGE(PG8_SA(0, 1), a2 + hstep, voffA);
            PG8_WAIT_V(8); PG8_WAIT_L(0); PG8_BAR; PG8_MMA(0, 0, At, B0); PG8_MMA(0, 1, At, B1); PG8_BAR; PG8_SCHED;
            PG8_LDA(At, 1, 1); PG8_STAGE(PG8_SB(1, 0), b3, voffB); PG8_STAGE(PG8_SB(1, 1), b3 + hstep, voffB); PG8_STAGE(PG8_SA(1, 0), a3, voffA);
            PG8_WAIT_V(8); PG8_WAIT_L(0); PG8_BAR; PG8_MMA(1, 0, At, B0); PG8_MMA(1, 1, At, B1); PG8_BAR; PG8_SCHED;
        }
        if (wr == 0) PG8_BAR;
        bool keep = false;
        if (S.mode == M_PROJ) {
            const float* RS = (const float*)(S.ws + WS_RSTD) + cur.pm * BM + wr * 64 + fr;
#pragma unroll
            for (int a = 0; a < 2; ++a)
#pragma unroll
                for (int m = 0; m < 4; ++m) { const float r = RS[a * HALF + m * 16];
#pragma unroll
                    for (int b = 0; b < 2; ++b)
#pragma unroll
                        for (int n = 0; n < 2; ++n) acc[a][b][m][n] *= r; }
            epi_proj(acc, cur, wr, wc, fr, fq, S.ws); }
        else if (S.mode == M_MERGE) { epi_merge(acc, cur, wr, wc, fr, fq, S.ws); keep = (cur.sub == 0); }
        else if (S.mode == M_OUT) epi_out(acc, cur, wr, wc, fr, fq, S.ws, S.xin, S.out);
        else epi_score(acc, cur, wr, wc, fr, fq, S.ws);
        if (!has_next) break;
        if (!keep) {
#pragma unroll
            for (int a = 0; a < 2; ++a)
#pragma unroll
                for (int b = 0; b < 2; ++b)
#pragma unroll
                    for (int m = 0; m < 4; ++m)
#pragma unroll
                        for (int n = 0; n < 2; ++n) acc[a][b][m][n] = (f32x4){0.f, 0.f, 0.f, 0.f};
        }
        cur = nxt; cA = nA; cB = nB; ++ui;
        if (wr == 1) PG8_BAR;
    }
    PG8_WAIT_V(0);
    PG8_BAR;
#undef PG8_SA
#undef PG8_SB
#undef PG8_STAGE
#undef PG8_LDA
#undef PG8_LDB
#undef PG8_MMA
#undef PG8_WAIT_V
#undef PG8_WAIT_L
#undef PG8_BAR
#undef PG8_SCHED
#undef PG8_UA
#undef PG8_UB
}
}

namespace attn_body {
using bf16 = __hip_bfloat16;
constexpr int NHEAD = 8, D = 64, DM = NHEAD * D;
constexpr int NW = 8, QBLK = 32, QB = QBLK * NW, KVBLK = 64, NQB = SEQ / QB;
__device__ __forceinline__ int crow(int r, int hi) { return (r & 3) + 8 * (r >> 2) + 4 * hi; }
#define SBAR() __builtin_amdgcn_sched_barrier(0)
constexpr int NSLOT = 3, SLOTB = 8192;
constexpr int LDS_K = 0, LDS_V = NSLOT * SLOTB, LDS_WS = 2 * NSLOT * SLOTB, LDS_OST = LDS_WS + NW * 64 * 4, LDS_M = LDS_OST + NW * 4096, LDS_TBL = LDS_M + NW * 2048, LDS_BYTES = LDS_TBL + 256;
__device__ __forceinline__ void glds16(const void* gsrc, unsigned lds_dst) { unsigned keep;
    asm volatile("s_mov_b32 %0, m0\n\ts_mov_b32 m0, %2\n\ts_nop 0\n\tglobal_load_lds_dwordx4 %1, off\n\ts_mov_b32 m0, %0" : "=&s"(keep) : "v"(gsrc), "s"(lds_dst) : "memory"); }
__device__ __forceinline__ float max3f(float a, float b, float c) { float r; asm("v_max3_f32 %0, %1, %2, %3" : "=v"(r) : "v"(a), "v"(b), "v"(c)); return r; }
__device__ __forceinline__ float max2f(float a, float b) { float r; asm("v_max_f32_e32 %0, %1, %2" : "=v"(r) : "v"(a), "v"(b)); return r; }
__device__ __forceinline__ float fadd_s(float a, float b) { float r; asm("v_add_f32_e32 %0, %1, %2" : "=v"(r) : "v"(a), "v"(b)); return r; }
__device__ __forceinline__ float fsub_s(float a, float b) { float r; asm("v_sub_f32_e32 %0, %1, %2" : "=v"(r) : "v"(a), "v"(b)); return r; }
typedef __bf16 bf16x2_t __attribute__((ext_vector_type(2)));
__device__ __forceinline__ unsigned cvtpk_s(float lo, float hi) { f32x2 v = {lo, hi}; bf16x2_t b = __builtin_convertvector(v, bf16x2_t); return __builtin_bit_cast(unsigned, b); }
#define WAIT_BAR(N) asm volatile("s_waitcnt vmcnt(" #N ") lgkmcnt(0)\n\ts_barrier" ::: "memory")
__device__ __forceinline__ void qkt(f32x16& p0, f32x16& p1, const char* Kslot, const bf16x8* qr, int r32, int hi) {
    const char* kb = Kslot + hi * 1024 + r32 * 16;
#pragma unroll
    for (int d0 = 0; d0 < 4; ++d0) {
        const bf16x8 b0 = *reinterpret_cast<const bf16x8*>(kb + d0 * 2048);
        const bf16x8 b1 = *reinterpret_cast<const bf16x8*>(kb + d0 * 2048 + 512);
        p0 = __builtin_amdgcn_mfma_f32_32x32x16_bf16(b0, qr[d0], p0, 0, 0, 0); p1 = __builtin_amdgcn_mfma_f32_32x32x16_bf16(b1, qr[d0], p1, 0, 0, 0); }
}
typedef LAS const char* lds_cptr;
typedef short v4i16_t __attribute__((ext_vector_type(4)));
__device__ __forceinline__ void kload8(bf16x8* kf, lds_cptr kp) {
    kf[0] = *(const LAS bf16x8*)(kp);        kf[1] = *(const LAS bf16x8*)(kp + 512);
    kf[2] = *(const LAS bf16x8*)(kp + 2048); kf[3] = *(const LAS bf16x8*)(kp + 2560);
    kf[4] = *(const LAS bf16x8*)(kp + 4096); kf[5] = *(const LAS bf16x8*)(kp + 4608);
    kf[6] = *(const LAS bf16x8*)(kp + 6144); kf[7] = *(const LAS bf16x8*)(kp + 6656);
}
__device__ __forceinline__ void kload2(bf16x8* kf, lds_cptr kp, int j) { kf[2 * j] = *(const LAS bf16x8*)(kp + j * 2048); kf[2 * j + 1] = *(const LAS bf16x8*)(kp + j * 2048 + 512); }
__device__ __forceinline__ s16x4 vtr(lds_cptr p) { return __builtin_bit_cast(s16x4, __builtin_amdgcn_ds_read_tr16_b64_v4i16((LAS v4i16_t*)p)); }
__device__ __forceinline__ float rowmax(const f32x16& p0, const f32x16& p1) {
    float a = max3f(p0[0], p0[1], p1[0]), b = max3f(p0[2], p0[3], p1[1]); a = max3f(a, p1[2], p1[3]);
#pragma unroll
    for (int r = 4; r < 16; r += 4) { a = max3f(a, p0[r], p0[r + 1]); b = max3f(b, p0[r + 2], p0[r + 3]); a = max3f(a, p1[r], p1[r + 1]); b = max3f(b, p1[r + 2], p1[r + 3]); }
    const float m = max2f(a, b);
    auto rr = __builtin_amdgcn_permlane32_swap(__float_as_uint(m), __float_as_uint(m), false, false);
    return max2f(__uint_as_float(rr[0]), __uint_as_float(rr[1]));
}
__device__ __forceinline__ void pv(f32x16* o, int vb, bf16x8 pa0, bf16x8 pa1, bf16x8 pa2, bf16x8 pa3) {
#pragma unroll
    for (int d0 = 0; d0 < 2; ++d0) { s16x4 lo[4], hi[4];
#pragma unroll
        for (int ks = 0; ks < 4; ++ks) {
            asm volatile("ds_read_b64_tr_b16 %0,%1 offset:%c2" : "=&v"(lo[ks]) : "v"(vb), "i"(d0 * 4096 + ks * 1024) : "memory");
            asm volatile("ds_read_b64_tr_b16 %0,%1 offset:%c2" : "=&v"(hi[ks]) : "v"(vb), "i"(d0 * 4096 + ks * 1024 + 512) : "memory"); }
        asm volatile("s_waitcnt lgkmcnt(0)" ::: "memory"); SBAR();
#define PK(k) (bf16x8){lo[k][0], lo[k][1], lo[k][2], lo[k][3], hi[k][0], hi[k][1], hi[k][2], hi[k][3]}
        o[d0] = __builtin_amdgcn_mfma_f32_32x32x16_bf16(pa0, PK(0), o[d0], 0, 0, 0);
        o[d0] = __builtin_amdgcn_mfma_f32_32x32x16_bf16(pa1, PK(1), o[d0], 0, 0, 0);
        o[d0] = __builtin_amdgcn_mfma_f32_32x32x16_bf16(pa2, PK(2), o[d0], 0, 0, 0);
        o[d0] = __builtin_amdgcn_mfma_f32_32x32x16_bf16(pa3, PK(3), o[d0], 0, 0, 0);
#undef PK
    }
}
__device__ __forceinline__ void mask_init(f32x16& p0, f32x16& p1, lds_cptr mp, lds_cptr tbl, int hi, float nm) {
    const u32x2 mw = *(const LAS u32x2*)mp;
    const unsigned lo = mw.x >> (4 * hi), hh = mw.y >> (4 * hi);
#pragma unroll
    for (int g = 0; g < 4; ++g) {
        const f32x4 b0 = *(const LAS f32x4*)(tbl + ((lo >> (8 * g)) & 15u) * 16);
        const f32x4 b1 = *(const LAS f32x4*)(tbl + ((hh >> (8 * g)) & 15u) * 16);
#pragma unroll
        for (int j = 0; j < 4; ++j) { p0[4 * g + j] = b0[j] + nm; p1[4 * g + j] = b1[j] + nm; }
    }
}
__device__ __forceinline__ void mask_load(f32x16& p0, f32x16& p1, u32x2 mw, lds_cptr tbl, int hi) {
    const unsigned lo = mw.x >> (4 * hi), hh = mw.y >> (4 * hi);
#pragma unroll
    for (int g = 0; g < 4; ++g) {
        const f32x4 b0 = *(const LAS f32x4*)(tbl + ((lo >> (8 * g)) & 15u) * 16);
        const f32x4 b1 = *(const LAS f32x4*)(tbl + ((hh >> (8 * g)) & 15u) * 16);
#pragma unroll
        for (int j = 0; j < 4; ++j) { p0[4 * g + j] = b0[j]; p1[4 * g + j] = b1[j]; }
    }
}
__device__ __forceinline__ void mask_add(f32x16& p0, f32x16& p1, float nm) {
#pragma unroll
    for (int r = 0; r < 16; ++r) { p0[r] += nm; p1[r] += nm; }
}
template <int THRL> __device__ __forceinline__ void attn_unit(int b, int h, int qb, const bf16* Q, const bf16* __restrict__ K, const bf16* __restrict__ V, bf16* O, const unsigned long long* BMp, char* shm) {
    const int tid = threadIdx.x, lane = tid & 63, r32 = lane & 31, hi = lane >> 5; const int wid = __builtin_amdgcn_readfirstlane(tid >> 6);
    const long rowbase = (long)b * SEQ; const int q0 = qb * QB;
    const bf16* Qw = Q + (rowbase + q0 + wid * QBLK) * DM + h * D;
    const bf16* Kh = K + rowbase * DM + h * D, *Vh = V + rowbase * DM + h * D;
    const unsigned lds0 = (unsigned)(uintptr_t)shm;
    float* wsf = (float*)(shm + LDS_WS) + wid * 64;
    const bf16* ksrc = Kh + (long)lane * DM + wid * 8;
    const bf16* vsrc = Vh + (long)(16 * (wid & 3) + (lane >> 2)) * DM + (wid >> 2) * 32 + (lane & 3) * 8;
    const unsigned kdst = lds0 + LDS_K + wid * 1024, vdst = lds0 + LDS_V + wid * 1024;
    const unsigned long long* msrc = BMp + ((size_t)(b * 128 + (lane >> 4)) * SEQ + q0 + wid * QBLK + 2 * (lane & 15));
    const unsigned mdst = lds0 + LDS_M + wid * 2048;
#define DMA_K(t, slot) glds16(ksrc + (long)(t) * KVBLK * DM, (unsigned)__builtin_amdgcn_readfirstlane(kdst + (slot)))
#define DMA_V(t, slot) glds16(vsrc + (long)(t) * KVBLK * DM, (unsigned)__builtin_amdgcn_readfirstlane(vdst + (slot)))
#define DMA_M(g) glds16(msrc + (size_t)(g) * 4 * SEQ, (unsigned)__builtin_amdgcn_readfirstlane(mdst + ((g) & 1) * 1024))
    const int vb0 = (int)(lds0 + LDS_V) + ((lane >> 4) & 1) * 32 + (lane & 3) * 8 + (4 * hi + ((lane & 15) >> 2)) * 64;
    const char* Kbase = shm + LDS_K; bf16x8 kf[8];
    const lds_cptr shm3 = (lds_cptr)shm; const lds_cptr kp0 = shm3 + LDS_K + hi * 1024 + r32 * 16; const lds_cptr vp0 = shm3 + LDS_V + ((lane >> 4) & 1) * 32 + (lane & 3) * 8 + (4 * hi + ((lane & 15) >> 2)) * 64;
    const lds_cptr mp0 = shm3 + LDS_M + wid * 2048 + r32 * 8; const lds_cptr tblp = shm3 + LDS_TBL;
    const int NT = (q0 + QB) / KVBLK;
    DMA_M(0); DMA_K(0, 0); DMA_V(0, 0); DMA_K(1, SLOTB);
    bf16x8 qr[4];
#pragma unroll
    for (int d0 = 0; d0 < 4; ++d0) qr[d0] = *reinterpret_cast<const bf16x8*>(&Qw[(long)r32 * DM + d0 * 16 + hi * 8]);
    float mhat = 0.f, l_reg = 0.f; f32x16 o[2]; o[0] = f32x16{}; o[1] = f32x16{};
#define MINIT(P0, P1, t) mask_init(P0, P1, mp0 + ((((t) >> 2) & 1) * 1024 + ((t) & 3) * 256), tblp, hi, -mhat)
#define MWORD(t) (*(const LAS u32x2*)(mp0 + ((((t) >> 2) & 1) * 1024 + ((t) & 3) * 256)))
    bool resc = false;
#define START(P0, P1) do { const float rm = rowmax(P0, P1); resc = false; \
    { const float dl = __builtin_fmaxf(rm, -64.f); mhat = fadd_s(mhat, dl); \
      _Pragma("unroll") for (int r = 0; r < 16; ++r) { P0[r] = fsub_s(P0[r], dl); P1[r] = fsub_s(P1[r], dl); } \
    } \
    _Pragma("unroll") for (int r = 0; r < 16; ++r) P0[r] = __builtin_amdgcn_exp2f(P0[r]); } while (0)
#define RESC() do { if (resc) { asm volatile("s_waitcnt lgkmcnt(0)" ::: "memory"); \
      _Pragma("unroll") for (int d_ = 0; d_ < 2; ++d_) _Pragma("unroll") for (int r = 0; r < 16; ++r) o[d_][r] *= wsf[crow(r, hi)]; } } while (0)
    f32x16 pA0, pA1, pB0, pB1;
    int sl_prev = 0, sl_cur = 0, sl_next = SLOTB;
#define ROT() do { sl_prev = sl_cur; sl_cur = sl_next; sl_next = (sl_next == (NSLOT - 1) * SLOTB) ? 0 : sl_next + SLOTB; } while (0)
    DMA_K(2, 2 * SLOTB);
    WAIT_BAR(3);
    MINIT(pA0, pA1, 0);
    qkt(pA0, pA1, Kbase, qr, r32, hi); asm volatile("s_nop 15\n\ts_nop 7" : "+v"(pA0), "+v"(pA1));
    START(pA0, pA1);
    _Pragma("unroll") for (int r = 0; r < 16; ++r) pA1[r] = __builtin_amdgcn_exp2f(pA1[r]);
    WAIT_BAR(0);
    DMA_K(3, 0); DMA_V(1, SLOTB);
    ROT();
    kload8(kf, kp0 + sl_cur);
    mask_load(pB0, pB1, MWORD(1), tblp, hi);
    WAIT_BAR(2);
    s16x4 vlo[8], vhi[8]; u32x4 pw0, pw1, pw2, pw3;
#define PKW(P, B) cvtpk_s(P[B], P[B + 1])
#define PAF(k) __builtin_bit_cast(bf16x8, pw##k)
#define VFR(i) (bf16x8){vlo[i][0], vlo[i][1], vlo[i][2], vlo[i][3], vhi[i][0], vhi[i][1], vhi[i][2], vhi[i][3]}
#define PIN(x) asm volatile("" : "+v"(x))
#define MX3(a, b, c) __builtin_fmaxf(__builtin_fmaxf((a), (b)), (c))
#define GAPA(MF, A0, A1, A2, A3, W0, W1, PW) do { MF; sacc += A0; sacc += A1; sacc += A2; sacc += A3; PIN(sacc); W0; W1; PIN(PW); SBAR(); } while (0)
#define EX(v) __builtin_amdgcn_exp2f(v)
#define GAPB(MF, X, B) do { MF; X[B] = EX(X[B]); X[B + 1] = EX(X[B + 1]); X[B + 2] = EX(X[B + 2]); X[B + 3] = EX(X[B + 3]); PIN(X); SBAR(); } while (0)
#define VRD(i) do { vlo[i] = vtr(vp_ + (((i) >> 2) * 4096 + ((i) & 3) * 1024)); vhi[i] = vtr(vp_ + (((i) >> 2) * 4096 + ((i) & 3) * 1024 + 512)); } while (0)
#define KRD(G, j) do { if (G) { kload2(kf, kp0 + sl_next, j); SBAR(); } } while (0)
#define STEP(C0, C1, P0, P1, t, GK, GV, GL) do { SBAR(); \
    u32x2 mwn_ = {0u, 0u}; if ((t) + 1 < NT) mwn_ = MWORD((t) + 1); \
    mask_add(C0, C1, -mhat); SBAR(); \
    const lds_cptr vp_ = vp0 + sl_prev; \
    VRD(0); SBAR(); float sacc = (P0[0] + P0[1]); \
    GAPA(C0 = __builtin_amdgcn_mfma_f32_32x32x16_bf16(kf[0], qr[0], C0, 0, 0, 0), P0[2], P0[3], P0[4], P0[5],     pw0[0] = PKW(P0, 0), pw0[1] = PKW(P0, 2), pw0); \
    VRD(4); SBAR(); GAPA(C1 = __builtin_amdgcn_mfma_f32_32x32x16_bf16(kf[1], qr[0], C1, 0, 0, 0), P0[6], P0[7], P0[8], P0[9],     pw0[2] = PKW(P0, 4), pw0[3] = PKW(P0, 6), pw0); \
    VRD(1); SBAR(); GAPA(C0 = __builtin_amdgcn_mfma_f32_32x32x16_bf16(kf[2], qr[1], C0, 0, 0, 0),   P0[10], P0[11], P0[12], P0[13], pw1[0] = PKW(P0, 8), pw1[1] = PKW(P0, 10), pw1); \
    VRD(5); SBAR(); GAPA(C1 = __builtin_amdgcn_mfma_f32_32x32x16_bf16(kf[3], qr[1], C1, 0, 0, 0),   P0[14], P0[15], P1[0], P1[1],   pw1[2] = PKW(P0, 12), pw1[3] = PKW(P0, 14), pw1); \
    VRD(2); SBAR(); GAPA(C0 = __builtin_amdgcn_mfma_f32_32x32x16_bf16(kf[4], qr[2], C0, 0, 0, 0),   P1[2], P1[3], P1[4], P1[5],     pw2[0] = PKW(P1, 0), pw2[1] = PKW(P1, 2), pw2); \
    VRD(6); SBAR(); GAPA(C1 = __builtin_amdgcn_mfma_f32_32x32x16_bf16(kf[5], qr[2], C1, 0, 0, 0),   P1[6], P1[7], P1[8], P1[9],     pw2[2] = PKW(P1, 4), pw2[3] = PKW(P1, 6), pw2); \
    VRD(3); SBAR(); GAPA(C0 = __builtin_amdgcn_mfma_f32_32x32x16_bf16(kf[6], qr[3], C0, 0, 0, 0),   P1[10], P1[11], P1[12], P1[13], pw3[0] = PKW(P1, 8), pw3[1] = PKW(P1, 10), pw3); \
    VRD(7); SBAR(); GAPA(C1 = __builtin_amdgcn_mfma_f32_32x32x16_bf16(kf[7], qr[3], C1, 0, 0, 0),   P1[14], P1[15], 0.f, 0.f,       pw3[2] = PKW(P1, 12), pw3[3] = PKW(P1, 14), pw3); \
    l_reg += sacc; \
    if ((((t) & 3) == 1) && ((t) + 3 < NT)) { DMA_M(((t) >> 2) + 1); } \
    if (GK) { DMA_K((t) + 3, sl_cur); } if (GV) { DMA_V((t) + 1, sl_next); } \
    { float a = MX3(C0[0], C0[1], C1[0]), b = MX3(C0[2], C0[3], C1[1]); a = MX3(a, C1[2], C1[3]); \
      _Pragma("unroll") for (int r = 4; r < 16; r += 4) { a = MX3(a, C0[r], C0[r + 1]); b = MX3(b, C0[r + 2], C0[r + 3]); a = MX3(a, C1[r], C1[r + 1]); b = MX3(b, C1[r + 2], C1[r + 3]); } \
      float rm = __builtin_fmaxf(a, b); { auto rr = __builtin_amdgcn_permlane32_swap(__float_as_uint(rm), __float_as_uint(rm), false, false); rm = __builtin_fmaxf(__uint_as_float(rr[0]), __uint_as_float(rr[1])); } \
      resc = false; \
      if (__builtin_expect(__any(rm > (float)THRL), 0)) { const float dl = __builtin_fmaxf(rm, 0.f); mhat += dl; \
        _Pragma("unroll") for (int r = 0; r < 16; ++r) { C0[r] -= dl; C1[r] -= dl; } \
        const float f = __builtin_amdgcn_exp2f(-dl); l_reg *= f; if (hi == 0) wsf[r32] = f; resc = true; } } \
    if ((t) + 1 < NT) mask_load(P0, P1, mwn_, tblp, hi); \
    SBAR(); \
    GAPB(o[0] = __builtin_amdgcn_mfma_f32_32x32x16_bf16(PAF(0), VFR(0), o[0], 0, 0, 0), C0, 0); \
    GAPB(o[1] = __builtin_amdgcn_mfma_f32_32x32x16_bf16(PAF(0), VFR(4), o[1], 0, 0, 0), C0, 4); \
    KRD(GL, 0); GAPB(o[0] = __builtin_amdgcn_mfma_f32_32x32x16_bf16(PAF(1), VFR(1), o[0], 0, 0, 0), C0, 8); \
    KRD(GL, 1); GAPB(o[1] = __builtin_amdgcn_mfma_f32_32x32x16_bf16(PAF(1), VFR(5), o[1], 0, 0, 0), C0, 12); \
    KRD(GL, 2); GAPB(o[0] = __builtin_amdgcn_mfma_f32_32x32x16_bf16(PAF(2), VFR(2), o[0], 0, 0, 0), C1, 0); \
    KRD(GL, 3); GAPB(o[1] = __builtin_amdgcn_mfma_f32_32x32x16_bf16(PAF(2), VFR(6), o[1], 0, 0, 0), C1, 4); \
    GAPB(o[0] = __builtin_amdgcn_mfma_f32_32x32x16_bf16(PAF(3), VFR(3), o[0], 0, 0, 0), C1, 8); \
    GAPB(o[1] = __builtin_amdgcn_mfma_f32_32x32x16_bf16(PAF(3), VFR(7), o[1], 0, 0, 0), C1, 12); \
    } while (0)
    int t = 1;
    for (; t + 5 < NT; t += 2) {
        STEP(pB0, pB1, pA0, pA1, t, true, true, true);     WAIT_BAR(2); RESC(); ROT();
        STEP(pA0, pA1, pB0, pB1, t + 1, true, true, true);   WAIT_BAR(2); RESC(); ROT();
    }
#define ENDW(tt) do { if ((tt) + 3 < NT) { WAIT_BAR(2); } else if ((tt) + 2 < NT) { WAIT_BAR(1); } else { WAIT_BAR(0); } } while (0)
    for (; t + 1 < NT; t += 2) {
        STEP(pB0, pB1, pA0, pA1, t, (t + 3 < NT), (t + 1 < NT), (t + 1 < NT));       ENDW(t);   RESC(); ROT();
        STEP(pA0, pA1, pB0, pB1, t + 1, (t + 4 < NT), (t + 2 < NT), (t + 2 < NT));     ENDW(t + 1); RESC(); ROT();
    }
    STEP(pB0, pB1, pA0, pA1, NT - 1, false, false, false); RESC();
    { float sacc = pB0[0] + pB0[1]; _Pragma("unroll") for (int r = 2; r < 16; ++r) sacc += pB0[r]; _Pragma("unroll") for (int r = 0; r < 16; ++r) sacc += pB1[r]; l_reg += sacc;
      pw0 = (u32x4){PKW(pB0, 0), PKW(pB0, 2), PKW(pB0, 4), PKW(pB0, 6)}; pw1 = (u32x4){PKW(pB0, 8), PKW(pB0, 10), PKW(pB0, 12), PKW(pB0, 14)}; pw2 = (u32x4){PKW(pB1, 0), PKW(pB1, 2), PKW(pB1, 4), PKW(pB1, 6)}; pw3 = (u32x4){PKW(pB1, 8), PKW(pB1, 10), PKW(pB1, 12), PKW(pB1, 14)};
      SBAR(); pv(o, vb0 + sl_cur, PAF(0), PAF(1), PAF(2), PAF(3)); }
#undef PKW
#undef PAF
#undef VFR
#undef PIN
#undef MX3
#undef GAPA
#undef GAPB
#undef EX
#undef VRD
#undef KRD
#undef STEP
#undef ENDW
    { auto rr = __builtin_amdgcn_permlane32_swap(__float_as_uint(l_reg), __float_as_uint(l_reg), false, false); l_reg = __uint_as_float(rr[0]) + __uint_as_float(rr[1]); }
    if (hi == 0) wsf[32 + r32] = l_reg; asm volatile("s_waitcnt lgkmcnt(0)" ::: "memory");
    float rli[16];
#pragma unroll
    for (int r = 0; r < 16; ++r) rli[r] = __builtin_amdgcn_rcpf(wsf[32 + crow(r, hi)]);
    bf16* Ow = O + (rowbase + q0 + wid * QBLK) * DM + h * D;
    { bf16* stg = (bf16*)(shm + LDS_OST) + wid * 2048;
#pragma unroll
      for (int r = 0; r < 16; ++r) { const int orow = crow(r, hi);
#pragma unroll
          for (int d0 = 0; d0 < 2; ++d0) stg[orow * 64 + d0 * 32 + r32] = __float2bfloat16(o[d0][r] * rli[r]); }
      asm volatile("s_waitcnt lgkmcnt(0)" ::: "memory");
#pragma unroll
      for (int i = 0; i < 4; ++i) { const int row = i * 8 + (lane >> 3), ch = lane & 7; const u32x4 v = *(const u32x4*)(stg + row * 64 + ch * 8); *(u32x4*)(Ow + (long)row * DM + ch * 8) = v; } }
    asm volatile("s_waitcnt lgkmcnt(0)\n\ts_barrier" ::: "memory");
#undef DMA_K
#undef DMA_V
#undef DMA_M
#undef MINIT
#undef MWORD
#undef START
#undef RESC
#undef ROT
}
#undef SBAR
#undef WAIT_BAR
}

constexpr int RING_OFF = 0, RING_BYTES = 131072;
constexpr int LDSCTL_OFF = 139264, MISC_OFF = LDSCTL_OFF + 320;
constexpr int LDS_BYTES = 147456;
typedef GAS unsigned gu32;

#define XB_TMO      128
#define XB_XCNT(j)  (256  + 64 * (j))
#define XB_XSUB(j)  (1280 + 64 * (j))
#define XB_XGEN(j)  (2304 + 64 * (j))
#define XB_TOP      3328
#define XB_TOPGEN   3392
#define XCD_BAR_WORDS 3456
#define XB_SPIN_CAP (1u << 22)
__device__ __forceinline__ unsigned xb_ld(unsigned* p)              { return __hip_atomic_load(p, __ATOMIC_RELAXED, __HIP_MEMORY_SCOPE_AGENT); }
__device__ __forceinline__ unsigned xb_add(unsigned* p, unsigned v) { return __hip_atomic_fetch_add(p, v, __ATOMIC_RELAXED, __HIP_MEMORY_SCOPE_AGENT); }
__device__ __forceinline__ unsigned xb_xcc_id() { return (unsigned)__builtin_amdgcn_s_getreg((3 << 11) | 20) & 0xFu; }
#define XB_SPIN(cond, bar) do { unsigned _sp = 0; while (cond) { __builtin_amdgcn_s_sleep(1); \
    if ((++_sp & 255u) == 0u) { if (xb_ld(&(bar)[XB_TMO])) break; if (_sp > XB_SPIN_CAP) { atomicAdd(&(bar)[XB_TMO], 1u); break; } } } } while (0)
struct XcdBarrier { unsigned* bar; unsigned x; volatile LAS unsigned* st; };
__device__ __forceinline__ XcdBarrier xcd_barrier_post(unsigned* bar, volatile LAS unsigned* st) {
    XcdBarrier b; b.bar = bar; b.x = xb_xcc_id(); b.st = st;
    if (threadIdx.x == 0) (void)xb_add(&bar[XB_XCNT(b.x)], 1u);
    return b;
}
__device__ __forceinline__ void xcd_barrier_complete(unsigned* bar, unsigned x, unsigned& nloc, unsigned& nx) {
    const unsigned G = gridDim.x * gridDim.y * gridDim.z;
    unsigned sum, cnt, mine, sp = 0u;
    for (;;) {
        sum = 0u; cnt = 0u; mine = 0u;
#pragma unroll
        for (unsigned j = 0; j < 16; ++j) { const unsigned c = xb_ld(&bar[XB_XCNT(j)]); sum += c; cnt += (c > 0u) ? 1u : 0u; mine = (j == x) ? c : mine; }
        if (sum == G) break;
        __builtin_amdgcn_s_sleep(1);
        if ((++sp & 255u) == 0u) { if (xb_ld(&bar[XB_TMO])) break; if (sp > XB_SPIN_CAP) { atomicAdd(&bar[XB_TMO], 1u); break; } }
    }
    nloc = mine > 0u ? mine : 1u; nx = cnt > 0u ? cnt : 1u;
}
__device__ __forceinline__ void xcd_barrier(const XcdBarrier& b) {
    asm volatile("s_waitcnt vmcnt(0)" ::: "memory");
    __syncthreads();
    if (threadIdx.x == 0) {
        unsigned* bar = b.bar;
        __builtin_amdgcn_s_waitcnt(0);
        unsigned nloc = b.st[0], nx = b.st[1];
        if (nloc == 0u) { xcd_barrier_complete(bar, b.x, nloc, nx); b.st[0] = nloc; b.st[1] = nx; }
        const unsigned old = xb_add(&bar[XB_XSUB(b.x)], 1u);
        const unsigned gen = old / nloc;
        if (old + 1u == (gen + 1u) * nloc) {
            __builtin_amdgcn_fence(__ATOMIC_RELEASE, "agent");
            asm volatile("s_waitcnt vmcnt(0)" ::: "memory");
            const unsigned og = xb_add(&bar[XB_TOP], 1u);
            const unsigned tg = og / nx;
            if (og + 1u == (tg + 1u) * nx) xb_add(&bar[XB_TOPGEN], 1u);
            else XB_SPIN(xb_ld(&bar[XB_TOPGEN]) == tg, bar);
            __builtin_amdgcn_fence(__ATOMIC_ACQUIRE, "agent");
            xb_add(&bar[XB_XGEN(b.x)], 1u);
            asm volatile("s_waitcnt vmcnt(0)" ::: "memory");
        } else {
            XB_SPIN(xb_ld(&bar[XB_XGEN(b.x)]) == gen, bar);
            __builtin_amdgcn_fence(__ATOMIC_ACQUIRE, "agent");
            asm volatile("s_waitcnt vmcnt(0)" ::: "memory");
        }
    }
    __syncthreads();
}

struct Frame {
    LAS unsigned char* lds; unsigned char* ldsg;
    int tid, lane, wave, vcu, G;
    const float* in[13]; float* out; unsigned char* ws;
};

__device__ __forceinline__ int perm_part(int c) {
    const int hp = c & 63;
    if (hp >= 16) return c;
    const int q = hp >> 3, r = hp & 7;
    return (c & ~63) + ((r < 4) ? (4 * q + r) : (8 + 4 * q + (r - 4)));
}
__device__ __forceinline__ int win_src_col(int p) {
    const int tile = p >> 8, c = p & 255;
    if (tile <= 1) { const int head = (c & 127) >> 5, d = c & 31; return tile * 256 + head * 64 + ((c >= 128) ? 32 : 0) + d; }
    if (tile <= 5) return 512 + (tile - 2) * 256 + c;
    if (tile <= 9) return 1536 + (tile - 6) * 256 + perm_part(c);
    if (tile <= 11) return 2560 + (tile - 10) * 256 + c;
    if (tile == 12) return 3072 + perm_part(c);
    if (tile == 13) { if (c < 64) return 3328 + perm_part(c); if (c < 68) return 3392 + (c - 64); return -1; }
    return 3396 + (tile - 14) * 256 + c;
}
template <bool MAP> __device__ __forceinline__ void p0_transpose_item(const float* W, int K, int N, u16* WT, LAS float* scr, int item, int nblk, int lane, const float* gk = nullptr) {
    const int kb = item / nblk, nb = item % nblk, k0 = 64 * kb, n0 = 32 * nb;
    const int sc = MAP ? win_src_col(n0 + (lane & 31)) : (n0 + (lane & 31));
#pragma unroll
    for (int i = 0; i < 32; ++i) { const int kk = 2 * i + (lane >> 5); scr[kk * 33 + (lane & 31)] = (sc >= 0) ? W[(size_t)(k0 + kk) * N + sc] * (MAP ? gk[k0 + kk] : 1.0f) : 0.f; }
    LDS_WAIT(); asm volatile("" ::: "memory");
    const int c = lane & 7;
#pragma unroll
    for (int j = 0; j < 4; ++j) { const int n = (lane >> 3) + 8 * j; const LAS float* s = scr + (8 * c) * 33 + n;
        u32x4 o; o.x = f2bf(s[0 * 33]) | (f2bf(s[1 * 33]) << 16); o.y = f2bf(s[2 * 33]) | (f2bf(s[3 * 33]) << 16); o.z = f2bf(s[4 * 33]) | (f2bf(s[5 * 33]) << 16); o.w = f2bf(s[6 * 33]) | (f2bf(s[7 * 33]) << 16);
        *(u32x4*)(WT + (size_t)(n0 + n) * K + k0 + 8 * c) = o; }
    LDS_WAIT(); asm volatile("" ::: "memory");
}
__device__ __forceinline__ void p0_prologue(Frame& F) {
    const float* x = F.in[0]; const float* attn_norm = F.in[1]; const float* w_in = F.in[2];
    const float* w_ret_o = F.in[4]; const float* w_dsa_o = F.in[5]; const float* w_out = F.in[6]; const float* ffn_norm = F.in[7];
    const float* peer_wq = F.in[8]; const float* subkeys = F.in[9]; const float* peer_u = F.in[10]; const float* peer_v = F.in[11];
    unsigned char* ws = F.ws;
    {
        u16* WSC = (u16*)(ws + WS_WSC);
        const int lane = F.lane, l32 = lane & 31, hi = lane >> 5, ri = F.wave & 1, ci = F.wave >> 1;
        for (int item = F.vcu; item < 256; item += F.G) {
            const int blk = item >> 4, i0 = (item & 15) * 64 + 32 * ri, k0 = 32 * ci;
            const float* ap = peer_wq + (size_t)(i0 + l32) * 2048 + blk * 128 + 8 * hi;
            const float* bp = subkeys + (size_t)(blk * 128 + k0 + l32) * 128 + 8 * hi;
            f32x4 av[8][2], bv[8][2];
#pragma unroll
            for (int kk = 0; kk < 8; ++kk) { av[kk][0] = *(const f32x4*)(ap + 16 * kk); av[kk][1] = *(const f32x4*)(ap + 16 * kk + 4); bv[kk][0] = *(const f32x4*)(bp + 16 * kk); bv[kk][1] = *(const f32x4*)(bp + 16 * kk + 4); }
            f32x16 acc = {};
#pragma unroll
            for (int kk = 0; kk < 8; ++kk) {
                const u32x4 aw = {cvt_pk_bf16(av[kk][0][0], av[kk][0][1]), cvt_pk_bf16(av[kk][0][2], av[kk][0][3]), cvt_pk_bf16(av[kk][1][0], av[kk][1][1]), cvt_pk_bf16(av[kk][1][2], av[kk][1][3])};
                const u32x4 bw = {cvt_pk_bf16(bv[kk][0][0], bv[kk][0][1]), cvt_pk_bf16(bv[kk][0][2], bv[kk][0][3]), cvt_pk_bf16(bv[kk][1][0], bv[kk][1][1]), cvt_pk_bf16(bv[kk][1][2], bv[kk][1][3])};
                acc = __builtin_amdgcn_mfma_f32_32x32x16_bf16(__builtin_bit_cast(bf16x8, aw), __builtin_bit_cast(bf16x8, bw), acc, 0, 0, 0);
            }
#pragma unroll
            for (int q = 0; q < 4; ++q) { const int ib = i0 + 8 * q + 4 * hi; const f32x4 gn = *(const f32x4*)(ffn_norm + ib);
                u32x2 w; w.x = cvt_pk_bf16(acc[4 * q] * gn[0], acc[4 * q + 1] * gn[1]); w.y = cvt_pk_bf16(acc[4 * q + 2] * gn[2], acc[4 * q + 3] * gn[3]);
                *(u32x2*)(WSC + (size_t)(blk * 128 + k0 + l32) * 1024 + ib) = w; }
        }
    }
    LAS float* scr = (LAS float*)(F.lds + F.wave * 16384);
    const int gw = F.vcu * NWAVES + F.wave, NGW = F.G * NWAVES;
    constexpr int I_IN = 16 * (N1PAD / 32), I_RO = 8 * 32, I_DO = 8 * 32, I_OUT = 16 * 32;
    constexpr int NITEMS = I_IN + I_RO + I_DO + I_OUT;
    for (int it = gw; it < NITEMS; it += NGW) {
        int r = it;
        if (r < I_IN) { p0_transpose_item<true>(w_in, 1024, D_IN, (u16*)(ws + WS_WIN), scr, r, N1PAD / 32, F.lane, attn_norm); continue; } r -= I_IN;
        if (r < I_RO) { p0_transpose_item<false>(w_ret_o, 512, 1024, (u16*)(ws + WS_WRO), scr, r, 32, F.lane); continue; } r -= I_RO;
        if (r < I_DO) { p0_transpose_item<false>(w_dsa_o, 512, 1024, (u16*)(ws + WS_WDO), scr, r, 32, F.lane); continue; } r -= I_DO;
        p0_transpose_item<false>(w_out, 1024, 1024, (u16*)(ws + WS_WOUT), scr, r, 32, F.lane);
    }
    {
        u16* H = (u16*)(ws + WS_XB); float* RS = (float*)(ws + WS_RSTD);
        for (int m0 = gw; m0 < NTOK; m0 += 2 * NGW) {
            const int m1 = (m0 + NGW < NTOK) ? m0 + NGW : m0;
            const f32x4* xr0 = (const f32x4*)(x + (size_t)m0 * DMODEL) + F.lane; const f32x4* xr1 = (const f32x4*)(x + (size_t)m1 * DMODEL) + F.lane;
            f32x4 v0[4], v1[4]; float s0 = 0.f, s1 = 0.f;
#pragma unroll
            for (int j = 0; j < 4; ++j) { v0[j] = xr0[64 * j]; v1[j] = xr1[64 * j]; }
#pragma unroll
            for (int j = 0; j < 4; ++j) { s0 += (v0[j].x * v0[j].x + v0[j].y * v0[j].y) + (v0[j].z * v0[j].z + v0[j].w * v0[j].w); s1 += (v1[j].x * v1[j].x + v1[j].y * v1[j].y) + (v1[j].z * v1[j].z + v1[j].w * v1[j].w); }
            const float rstd0 = 1.0f / sqrtf(wave_sum(s0) * (1.f / DMODEL) + EPS), rstd1 = 1.0f / sqrtf(wave_sum(s1) * (1.f / DMODEL) + EPS);
            u32x2* o0 = (u32x2*)(H + (size_t)m0 * DMODEL) + F.lane; u32x2* o1 = (u32x2*)(H + (size_t)m1 * DMODEL) + F.lane;
#pragma unroll
            for (int j = 0; j < 4; ++j) { u32x2 w; w.x = cvt_pk_bf16(v0[j].x, v0[j].y); w.y = cvt_pk_bf16(v0[j].z, v0[j].w); o0[64 * j] = w;
                u32x2 w2; w2.x = cvt_pk_bf16(v1[j].x, v1[j].y); w2.y = cvt_pk_bf16(v1[j].z, v1[j].w); o1[64 * j] = w2; }
            if (F.lane == 0) { RS[m0] = rstd0; RS[m1] = rstd1; }
        }
    }
    {
        const int gwv = F.vcu * NWAVES + F.wave, NWV = F.G * NWAVES;
        unsigned* KUV = (unsigned*)(ws + WS_KUV);
        for (int r = gwv; r < 16384; r += NWV) {
            f32x4 a[2][4];
#pragma unroll
            for (int u = 0; u < 2; ++u) { const f32x4* src = (const f32x4*)((u ? peer_v : peer_u) + (size_t)r * 1024 + 16 * F.lane);
#pragma unroll
                for (int q = 0; q < 4; ++q) a[u][q] = src[q]; }
            unsigned kk = 0;
#pragma unroll
            for (int u = 0; u < 2; ++u) {
                float m = 0.f;
#pragma unroll
                for (int q = 0; q < 4; ++q) m = fmaxf(fmaxf(m, fmaxf(fabsf(a[u][q][0]), fabsf(a[u][q][1]))), fmaxf(fabsf(a[u][q][2]), fabsf(a[u][q][3])));
                m = wave_max(m);
                const int eb = (int)((__float_as_uint(m) >> 23) & 0xffu);
                int k = eb ? 129 - eb : 0; k = k < -64 ? -64 : (k > 63 ? 63 : k);
                const float sc = __uint_as_float((unsigned)(127 + k) << 23);
                unsigned c[16];
#pragma unroll
                for (int q = 0; q < 4; ++q)
#pragma unroll
                    for (int j = 0; j < 4; ++j) c[4 * q + j] = fp6_code(a[u][q][j] * sc);
                U3 w;
                w.x = c[0] | (c[1] << 6) | (c[2] << 12) | (c[3] << 18) | (c[4] << 24) | (c[5] << 30);
                w.y = (c[5] >> 2) | (c[6] << 4) | (c[7] << 10) | (c[8] << 16) | (c[9] << 22) | (c[10] << 28);
                w.z = (c[10] >> 4) | (c[11] << 2) | (c[12] << 8) | (c[13] << 14) | (c[14] << 20) | (c[15] << 26);
                *(U3*)(ws + (u ? WS_V : WS_U) + (size_t)r * 768 + 12 * F.lane) = w;
                kk |= (unsigned)(k + 64) << (8 * u);
            }
            if (F.lane == 0) KUV[r] = kk;
        }
        const size_t gt = (size_t)F.vcu * 512 + F.tid, NT_ = (size_t)F.G * 512;
        f32x2* ta = (f32x2*)(ws + WS_TABA); f32x2* tb = (f32x2*)(ws + WS_TABB);
        for (size_t i = gt; i < (size_t)SEQ * 40; i += NT_) {
            const int pos = (int)(i / 40), k = (int)(i % 40);
            const float inv = (k < 32) ? exp2f(-(float)k * (13.287712379549449f / 32.0f)) : exp2f(-(float)(k - 32) * (18.931568569324174f / 8.0f));
            const float ang = (float)pos * inv;
            float sn_, cs_; sincosf(ang, &sn_, &cs_);
            const f32x2 cs = {cs_, sn_};
            if (k < 32) ta[pos * 32 + k] = cs; else tb[pos * 8 + (k - 32)] = cs;
        }
    }
}

__device__ __forceinline__ float ret_logg(int h) { return logf(1.0f - exp2f(-5.0f - (float)h)); }
constexpr int RS_K = 72, RS_V = 136;
__device__ __forceinline__ bf16x8 gather8(const LAS u16* p, int stride) {
    bf16x8 v;
#pragma unroll
    for (int i = 0; i < 8; ++i) v[i] = (short)p[i * stride];
    return v;
}
struct KvIn { u32x4 k, v[2]; };
__device__ __forceinline__ void ret_kv_load(Frame& F, int item, KvIn& I) {
    const int h = item & 3, bn = item >> 2;
    const u16* RKp = (const u16*)(F.ws + WS_RK) + (size_t)bn * 64 * 256 + h * 64;
    const u16* RVp = (const u16*)(F.ws + WS_RV) + (size_t)bn * 64 * 512 + h * 128;
    { const int j = F.tid >> 3, c = (F.tid & 7) * 8; I.k = *(const u32x4*)(RKp + (size_t)j * 256 + c); }
#pragma unroll
    for (int i = 0; i < 2; ++i) { const int e = F.tid + 512 * i; const int j = e >> 4, c = (e & 15) * 8; I.v[i] = *(const u32x4*)(RVp + (size_t)j * 512 + c); }
}
__device__ __forceinline__ void ret_kv_item(Frame& F, int item, KvIn& I, int nxt) {
    const int h = item & 3;
    float* kvp = (float*)((unsigned char*)F.out + OUT_KV) + (size_t)item * 8192;
    LAS u16* Ks = (LAS u16*)F.lds; LAS u16* Vs = (LAS u16*)(F.lds + 64 * RS_K * 2);
    const float lg = ret_logg(h);
    { const int j = F.tid >> 3, c = (F.tid & 7) * 8;
      const u32x4 kv4 = I.k; const float dec = __expf(lg * (float)(63 - j));
      const unsigned w[4] = {kv4.x, kv4.y, kv4.z, kv4.w}; u32x4 o;
      unsigned r[4];
#pragma unroll
      for (int q = 0; q < 4; ++q) r[q] = cvt_pk_bf16(bf2f(w[q] & 0xffffu) * dec, bf2f(w[q] >> 16) * dec);
      o.x = r[0]; o.y = r[1]; o.z = r[2]; o.w = r[3];
      *(LAS u32x4*)(Ks + j * RS_K + c) = o; }
#pragma unroll
    for (int i = 0; i < 2; ++i) { const int e = F.tid + 512 * i; const int j = e >> 4, c = (e & 15) * 8;
      *(LAS u32x4*)(Vs + j * RS_V + c) = I.v[i]; }
    LDS_WAIT(); __builtin_amdgcn_s_barrier();
    if (nxt >= 0) ret_kv_load(F, nxt, I);
    const int td = F.wave >> 2, te = F.wave & 3, r32 = F.lane & 31, hi = F.lane >> 5;
    f32x16 acc = {};
#pragma unroll
    for (int kk = 0; kk < 4; ++kk) {
        const bf16x8 a = gather8(Ks + (16 * kk + 8 * hi) * RS_K + 32 * td + r32, RS_K);
        const bf16x8 bb = gather8(Vs + (16 * kk + 8 * hi) * RS_V + 32 * te + r32, RS_V);
        acc = __builtin_amdgcn_mfma_f32_32x32x16_bf16(a, bb, acc, 0, 0, 0);
    }
#pragma unroll
    for (int r = 0; r < 16; ++r) { const int d = 32 * td + (r & 3) + 8 * (r >> 2) + 4 * hi; kvp[d * 128 + 32 * te + r32] = acc[r]; }
    LDS_WAIT(); __builtin_amdgcn_s_barrier();
}
__device__ __forceinline__ void ret_scan(Frame& F) {
    float* kv = (float*)((unsigned char*)F.out + OUT_KV);
    for (int idx = F.vcu * 512 + F.tid; idx < 16 * 8192; idx += F.G * 512) {
        const int bh = idx >> 13, de = idx & 8191, b = bh >> 2, h = bh & 3;
        const float cd = __expf(ret_logg(h) * 64.0f);
        float* p = kv + ((size_t)(b * 128) * 4 + h) * 8192 + de;
        float s = 0.f;
        float ta[32], tb[32];
#define SCAN_LD(buf, n0) _Pragma("unroll") for (int i = 0; i < 32; ++i) buf[i] = p[(size_t)((n0) + i) * 4 * 8192]
#define SCAN_RUN(buf, n0) _Pragma("unroll") for (int i = 0; i < 32; ++i) { p[(size_t)((n0) + i) * 4 * 8192] = s; s = cd * s + buf[i]; }
        SCAN_LD(ta, 0); SCAN_LD(tb, 32);
        SCAN_RUN(ta, 0); SCAN_LD(ta, 64);
        SCAN_RUN(tb, 32); SCAN_LD(tb, 96);
        SCAN_RUN(ta, 64); SCAN_RUN(tb, 96);
#undef SCAN_LD
#undef SCAN_RUN
    }
}
struct OutIn { u32x4 q, k, v[2]; f32x4 p[2][2]; };
__device__ __forceinline__ void ret_out_load(Frame& F, int item, OutIn& I) {
    const int h = item & 3, bn = item >> 2; const size_t tok0 = (size_t)bn * 64;
    const u16* RQp = (const u16*)(F.ws + WS_RQ) + tok0 * 256 + h * 64; const u16* RKp = (const u16*)(F.ws + WS_RK) + tok0 * 256 + h * 64;
    const u16* RVp = (const u16*)(F.ws + WS_RV) + tok0 * 512 + h * 128;
    const float* kvp = (const float*)((unsigned char*)F.out + OUT_KV) + (size_t)item * 8192;
    { const int j = F.tid >> 3, c = (F.tid & 7) * 8; I.q = *(const u32x4*)(RQp + (size_t)j * 256 + c); I.k = *(const u32x4*)(RKp + (size_t)j * 256 + c); }
#pragma unroll
    for (int i = 0; i < 2; ++i) { const int e = F.tid + 512 * i; const int j = e >> 4, c = (e & 15) * 8;
        I.v[i] = *(const u32x4*)(RVp + (size_t)j * 512 + c); I.p[i][0] = *(const f32x4*)(kvp + j * 128 + c); I.p[i][1] = *(const f32x4*)(kvp + j * 128 + c + 4); }
}
__device__ __forceinline__ void ret_out_item(Frame& F, int item, OutIn& I, int nxt) {
    const int h = item & 3, bn = item >> 2;
    const size_t tok0 = (size_t)bn * 64;
    const u16* RGp = (const u16*)(F.ws + WS_RG) + tok0 * 512 + h * 128;
    const float* gn = F.in[3] + h * 128;
    u16* YR = (u16*)(F.ws + WS_YRET) + tok0 * 512 + h * 128;
    LAS u16* Qs = (LAS u16*)F.lds; LAS u16* Ks = Qs + 64 * RS_K; LAS u16* Vs = Ks + 64 * RS_K; LAS u16* Ps = Vs + 64 * RS_V;
    LAS u16* Sw = Ps + 64 * RS_V + F.wave * (32 * RS_K); LAS float* Ys = (LAS float*)(Ps + 64 * RS_V + 8 * 32 * RS_K);
    const float lg = ret_logg(h);
    { const int j = F.tid >> 3, c = (F.tid & 7) * 8;
      *(LAS u32x4*)(Qs + j * RS_K + c) = I.q;
      *(LAS u32x4*)(Ks + j * RS_K + c) = I.k; }
#pragma unroll
    for (int i = 0; i < 2; ++i) { const int e = F.tid + 512 * i; const int j = e >> 4, c = (e & 15) * 8;
      *(LAS u32x4*)(Vs + j * RS_V + c) = I.v[i];
      const f32x4 p0 = I.p[i][0], p1 = I.p[i][1];
      u32x4 w; w.x = cvt_pk_bf16(p0[0], p0[1]); w.y = cvt_pk_bf16(p0[2], p0[3]); w.z = cvt_pk_bf16(p1[0], p1[1]); w.w = cvt_pk_bf16(p1[2], p1[3]);
      *(LAS u32x4*)(Ps + j * RS_V + c) = w; }
    LDS_WAIT(); __builtin_amdgcn_s_barrier();
    if (nxt >= 0) ret_out_load(F, nxt, I);
    const int ti = F.wave >> 2, te = F.wave & 3, r32 = F.lane & 31, hi = F.lane >> 5;
#pragma unroll
    for (int tj = 0; tj < 2; ++tj) {
        f32x16 s = {};
#pragma unroll
        for (int kk = 0; kk < 4; ++kk) {
            const bf16x8 a = *(const LAS bf16x8*)(Qs + (32 * ti + r32) * RS_K + 16 * kk + 8 * hi);
            const bf16x8 bb = *(const LAS bf16x8*)(Ks + (32 * tj + r32) * RS_K + 16 * kk + 8 * hi);
            s = __builtin_amdgcn_mfma_f32_32x32x16_bf16(a, bb, s, 0, 0, 0);
        }
#pragma unroll
        for (int r = 0; r < 16; ++r) { const int il = (r & 3) + 8 * (r >> 2) + 4 * hi; const int dd = (32 * ti + il) - (32 * tj + r32);
            Sw[il * RS_K + 32 * tj + r32] = (u16)f2bf(s[r] * __expf(lg * fabsf((float)dd))); }
    }
    LDS_WAIT();
    f32x16 y = {}, cr = {};
#pragma unroll
    for (int kk = 0; kk < 4; ++kk) {
        const bf16x8 a = *(const LAS bf16x8*)(Sw + r32 * RS_K + 16 * kk + 8 * hi);
        const bf16x8 bb = gather8(Vs + (16 * kk + 8 * hi) * RS_V + 32 * te + r32, RS_V);
        y = __builtin_amdgcn_mfma_f32_32x32x16_bf16(a, bb, y, 0, 0, 0);
        const bf16x8 a2 = *(const LAS bf16x8*)(Qs + (32 * ti + r32) * RS_K + 16 * kk + 8 * hi);
        const bf16x8 b2 = gather8(Ps + (16 * kk + 8 * hi) * RS_V + 32 * te + r32, RS_V);
        cr = __builtin_amdgcn_mfma_f32_32x32x16_bf16(a2, b2, cr, 0, 0, 0);
    }
#pragma unroll
    for (int r = 0; r < 16; ++r) { const int i = 32 * ti + (r & 3) + 8 * (r >> 2) + 4 * hi;
        Ys[i * 132 + 32 * te + r32] = y[r] + cr[r] * __expf(lg * (float)(i + 1)); }

    LDS_WAIT(); __builtin_amdgcn_s_barrier();
    { const int i = F.tid >> 3, sg = (F.tid & 7) * 16;
      float v[16]; float s = 0.f;
#pragma unroll
      for (int q = 0; q < 4; ++q) { const f32x4 t = *(const LAS f32x4*)(Ys + i * 132 + sg + 4 * q); v[4 * q] = t[0]; v[4 * q + 1] = t[1]; v[4 * q + 2] = t[2]; v[4 * q + 3] = t[3]; s += (t[0] + t[1]) + (t[2] + t[3]); }
      s += dppf<0xB1>(s); s += dppf<0x4E>(s); s += dppf<0x141>(s);
      const float mu = s * (1.f / 128.f); float q2 = 0.f;
#pragma unroll
      for (int q = 0; q < 16; ++q) { v[q] -= mu; q2 += v[q] * v[q]; }
      q2 += dppf<0xB1>(q2); q2 += dppf<0x4E>(q2); q2 += dppf<0x141>(q2);
      const float rstd = 1.0f / sqrtf(q2 * (1.f / 128.f) + EPS);
      const u32x4 g0 = *(const u32x4*)(RGp + (size_t)i * 512 + sg), g1 = *(const u32x4*)(RGp + (size_t)i * 512 + sg + 8);
      const unsigned gw_[8] = {g0.x, g0.y, g0.z, g0.w, g1.x, g1.y, g1.z, g1.w};
      unsigned ow[8];
#pragma unroll
      for (int q = 0; q < 8; ++q) { const float a = v[2 * q] * rstd * gn[sg + 2 * q] * bf2f(gw_[q] & 0xffffu), bq = v[2 * q + 1] * rstd * gn[sg + 2 * q + 1] * bf2f(gw_[q] >> 16); ow[q] = cvt_pk_bf16(a, bq); }
      *(u32x4*)(YR + (size_t)i * 512 + sg) = (u32x4){ow[0], ow[1], ow[2], ow[3]}; *(u32x4*)(YR + (size_t)i * 512 + sg + 8) = (u32x4){ow[4], ow[5], ow[6], ow[7]}; }
    LDS_WAIT(); __builtin_amdgcn_s_barrier();
}

__device__ __forceinline__ void bt16(unsigned (&x)[16]) {
#pragma unroll
    for (int j = 0; j < 8; ++j) { const unsigned a = x[j], b = x[j + 8]; x[j] = __builtin_amdgcn_perm(b, a, 0x06020400u); x[j + 8] = __builtin_amdgcn_perm(b, a, 0x07030501u); }
#define BT_STAGE(s, m) _Pragma("unroll") for (int j = 0; j < 16; ++j) if (!(j & s)) { const unsigned a = x[j], b = x[j + s]; x[j] = (a & m) | ((b << s) & ~m); x[j + s] = ((a >> s) & m) | (b & ~m); }
    BT_STAGE(4, 0x0F0F0F0Fu) BT_STAGE(2, 0x33333333u) BT_STAGE(1, 0x55555555u)
#undef BT_STAGE
}
__device__ __forceinline__ float relu_s(float x) { return __builtin_amdgcn_fmed3f(x, 0.0f, 3.0e38f); }
constexpr int IDX_WST = 131072;
struct IdxPre { f16x8 qa[4]; f32x4 wv[4]; f16x8 b0[2][4], b1[2][4]; };
__device__ __forceinline__ void idx_prefetch(Frame& F, int grp, IdxPre& P) {
    const int b = grp >> 10, t0 = (grp & 1023) * 8, ntile32 = 2 * ((t0 >> 6) + 1);
    const size_t tokbase = (size_t)b * SEQ;
    const int lane = F.lane, wid = F.wave, r32 = lane & 31, hi = lane >> 5;
    const _Float16* IQ = (const _Float16*)(F.ws + WS_IQ); const _Float16* IK = (const _Float16*)(F.ws + WS_IK); const float* IW = (const float*)(F.ws + WS_IW);
    const _Float16* qp = IQ + (tokbase + t0 + (r32 >> 2)) * 256 + (r32 & 3) * 64 + 8 * hi;
#pragma unroll
    for (int kk = 0; kk < 4; ++kk) P.qa[kk] = *(const f16x8*)(qp + 16 * kk);
#pragma unroll
    for (int jq = 0; jq < 4; ++jq) P.wv[jq] = *(const f32x4*)(IW + (tokbase + t0 + 2 * jq + hi) * 4) * 1024.0f;
#pragma unroll
    for (int u = 0; u < 2; ++u) {
        const int Ta_ = wid + NWAVES * u, Tb_ = wid + NWAVES * (2 + u);
        const int Ta = Ta_ < ntile32 ? Ta_ : ntile32 - 1, Tb = Tb_ < ntile32 ? Tb_ : ntile32 - 1;
        const _Float16* ka = IK + ((tokbase >> 5) + Ta) * 2048 + lane * 8; const _Float16* kb = IK + ((tokbase >> 5) + Tb) * 2048 + lane * 8;
#pragma unroll
        for (int kk = 0; kk < 4; ++kk) { P.b0[u][kk] = *(const f16x8*)(ka + 512 * kk); P.b1[u][kk] = *(const f16x8*)(kb + 512 * kk); }
    }
}
__device__ __forceinline__ void indexer_group(Frame& F, int grp, int nxt, IdxPre& P) {
    const int b = grp >> 10, g8 = grp & 1023, t0 = g8 * 8, chunk = t0 >> 6, nt64 = chunk + 1;
    const size_t tokbase = (size_t)b * SEQ;
    const int nwords = 4 * (chunk >> 2) + 4;
    unsigned long long* BMp = (unsigned long long*)((unsigned char*)F.out + OUT_BM);
    LAS u16* sc = (LAS u16*)F.lds;
    LAS unsigned long long* wst = (LAS unsigned long long*)(F.lds + IDX_WST);
    const int lane = F.lane, wid = F.wave, r32 = lane & 31, hi = lane >> 5;
    if (nt64 <= 4) {
        if (F.tid < nwords * 4) { const int i = F.tid >> 2, part = F.tid & 3; const unsigned long long w = (i < nt64) ? ~0ull : 0ull;
            unsigned long long* dst = BMp + ((size_t)(b * 128 + i) * SEQ + t0 + 2 * part); dst[0] = w; dst[1] = w; }
        idx_prefetch(F, nxt, P);
        return;
    }
    {
        const _Float16* IK = (const _Float16*)(F.ws + WS_IK);
        f16x8 (&qa)[4] = P.qa; f32x4 (&wv)[4] = P.wv;
        const int ntile32 = nt64 * 2;
        const int rotl = 2 * (r32 & 15) + hi, lofs = hi * 8192 + (r32 & 15) * 128 + (r32 >> 4);
#define IDX_LOAD(buf, trip) do { _Pragma("unroll") for (int u = 0; u < 2; ++u) { const int T_ = wid + NWAVES * (2 * (trip) + u); const int T = T_ < ntile32 ? T_ : ntile32 - 1; { const _Float16* kp = IK + ((tokbase >> 5) + T) * 2048 + lane * 8; \
            _Pragma("unroll") for (int kk = 0; kk < 4; ++kk) buf[u][kk] = *(const f16x8*)(kp + 512 * kk); } } } while (0)
#define IDX_COMP(buf, trip) do { _Pragma("unroll") for (int u = 0; u < 2; ++u) { const int T_ = wid + NWAVES * (2 * (trip) + u); const int T = T_ < ntile32 ? T_ : ntile32 - 1; { \
            f32x16 acc = {}; \
            __builtin_amdgcn_s_setprio(1); \
            _Pragma("unroll") for (int kk = 0; kk < 4; ++kk) acc = __builtin_amdgcn_mfma_f32_32x32x16_f16(qa[kk], buf[u][kk], acc, 0, 0, 0); \
            __builtin_amdgcn_s_setprio(0); \
            const int wofs = (((T >> 6) * 16 * 64 + (((T & 63) + rotl) & 63)) << 1) + lofs;        \
            _Pragma("unroll") for (int jq = 0; jq < 4; ++jq) { \
                float s = __builtin_fmaf(wv[jq][0], relu_s(acc[4 * jq]), 49152.0f); \
                s = __builtin_fmaf(wv[jq][1], relu_s(acc[4 * jq + 1]), s); s = __builtin_fmaf(wv[jq][2], relu_s(acc[4 * jq + 2]), s); s = __builtin_fmaf(wv[jq][3], relu_s(acc[4 * jq + 3]), s); \
                  \
                const unsigned kq = (unsigned)__builtin_amdgcn_fmed3f(s, 32768.0f, 65535.0f);        \
                sc[2 * jq * 8192 + wofs] = (u16)kq; } } } } while (0)
        {
            const int ntrips = (ntile32 + 2 * NWAVES - 1) / (2 * NWAVES);
            f16x8 (&b0)[2][4] = P.b0; f16x8 (&b1)[2][4] = P.b1; f16x8 b2[2][4];
            {
            for (int i = 0; i < ntrips; i += 3) {
                IDX_LOAD(b2, i + 2); IDX_COMP(b0, i);
                if (i + 1 >= ntrips) break;
                IDX_LOAD(b0, i + 3); IDX_COMP(b1, i + 1);
                if (i + 2 >= ntrips) break;
                IDX_LOAD(b1, i + 4); IDX_COMP(b2, i + 2);
            }
            }
        }
#undef IDX_LOAD
#undef IDX_COMP
    }
    idx_prefetch(F, nxt, P);
    LDS_WAIT(); __builtin_amdgcn_s_barrier();
    {
        const int nblk = 2 * nt64;
        const LAS unsigned* row = (const LAS unsigned*)(sc + wid * 8192);
        unsigned P[4][16];
#pragma unroll
        for (int c = 0; c < 4; ++c) {
            if (c * 64 < nblk) {
                const bool valid = c * 64 + lane < nblk;
#pragma unroll
                for (int j = 0; j < 16; ++j) { const unsigned v = row[(c * 16 + j) * 64 + ((lane + 2 * j + (wid & 1)) & 63)]; P[c][j] = valid ? v : 0u; }
                bt16(P[c]);
            } else {
#pragma unroll
                for (int j = 0; j < 16; ++j) P[c][j] = 0u;
            }
        }
        unsigned A[4], G[4];
#pragma unroll
        for (int c = 0; c < 4; ++c) { A[c] = P[c][15]; G[c] = 0u; }
        int cntG = 0;
#pragma unroll
        for (int bit = 14; bit >= 0; --bit) {
            unsigned t[4]; int n = 0;
#pragma unroll
            for (int c = 0; c < 4; ++c) { t[c] = A[c] & P[c][bit]; n += (int)__builtin_popcount(t[c]); }
            const int n1 = __builtin_amdgcn_readfirstlane(wave_sum_i(n));
            if (cntG + n1 >= 256) {
#pragma unroll
                for (int c = 0; c < 4; ++c) A[c] = t[c];
            } else {
#pragma unroll
                for (int c = 0; c < 4; ++c) { G[c] |= t[c]; A[c] ^= t[c]; }
                cntG += n1;
            }
        }
        const int need = 256 - cntG;
        int na = 0;
#pragma unroll
        for (int c = 0; c < 4; ++c) na += (int)__builtin_popcount(A[c]);
        const int ntie = __builtin_amdgcn_readfirstlane(wave_sum_i(na));
        if (ntie > need) {
            int run = 0;
#pragma unroll
            for (int c = 0; c < 4; ++c) {
                const int pc = (int)__builtin_popcount(A[c]);
                int incl = pc;
#pragma unroll
                for (int o = 1; o < 64; o <<= 1) { const int v = __shfl_up(incl, o); if (lane >= o) incl += v; }
                int k = need - (run + incl - pc); k = k < 0 ? 0 : k;
                unsigned av = A[c];
                while ((int)__builtin_popcount(av) > k) av &= ~(0x80000000u >> __builtin_clz(av));
                A[c] = av;
                run += __builtin_amdgcn_readlane(incl, 63);
            }
        }
        LAS unsigned* wst32 = (LAS unsigned*)wst;
#pragma unroll
        for (int c = 0; c < 4; ++c) wst32[((c * 32 + (lane >> 1)) * 8 + wid) * 2 + (lane & 1)] = G[c] | A[c];
    }
    LDS_WAIT(); __builtin_amdgcn_s_barrier();
    if (F.tid < nwords * 4) { const int i = F.tid >> 2, part = F.tid & 3;
        const unsigned long long a = wst[i * 8 + 2 * part], c = wst[i * 8 + 2 * part + 1];
        unsigned long long* dst = BMp + ((size_t)(b * 128 + i) * SEQ + t0 + 2 * part); dst[0] = a; dst[1] = c; }
}

__device__ __forceinline__ float dot2bf(unsigned a, unsigned b, float c) { return __builtin_amdgcn_fdot2_f32_bf16(__builtin_bit_cast(bf16x2v, a), __builtin_bit_cast(bf16x2v, b), c, false); }
__device__ __forceinline__ unsigned f16key(unsigned bits) { return (bits & 0x8000u) ? (~bits & 0xffffu) : (bits | 0x8000u); }
__device__ __forceinline__ float f16key_val(unsigned key) { const unsigned bits = (key & 0x8000u) ? (key & 0x7fffu) : (~key & 0xffffu); return (float)__builtin_bit_cast(_Float16, (u16)bits); }
__device__ __forceinline__ unsigned f32key(float f) { const unsigned u = __builtin_bit_cast(unsigned, f); return (u & 0x80000000u) ? ~u : (u | 0x80000000u); }
#define CE(a, b) do { const unsigned _x = a > b ? a : b, _y = a > b ? b : a; a = _x; b = _y; } while (0)
__device__ __forceinline__ void top16_of_128(const u32x4 raw, int li, float& val, int& idx) {
    unsigned e[8];
    const unsigned w[4] = {raw.x, raw.y, raw.z, raw.w};
#pragma unroll
    for (int q = 0; q < 4; ++q) { e[2 * q] = (f16key(w[q] & 0xffffu) << 16) | (unsigned)(li * 8 + 2 * q); e[2 * q + 1] = (f16key(w[q] >> 16) << 16) | (unsigned)(li * 8 + 2 * q + 1); }
    CE(e[0], e[1]); CE(e[2], e[3]); CE(e[4], e[5]); CE(e[6], e[7]);
    CE(e[0], e[2]); CE(e[1], e[3]); CE(e[4], e[6]); CE(e[5], e[7]);
    CE(e[1], e[2]); CE(e[5], e[6]); CE(e[0], e[4]); CE(e[3], e[7]);
    CE(e[1], e[5]); CE(e[2], e[6]);
    CE(e[1], e[4]); CE(e[3], e[6]);
    CE(e[2], e[4]); CE(e[3], e[5]);
    CE(e[3], e[4]);
    unsigned mine = 0;
#pragma unroll
    for (int r = 0; r < 16; ++r) {
        const unsigned M = row16_maxu(e[0]);
        if (li == r) mine = M;
        if (e[0] == M) { e[0] = e[1]; e[1] = e[2]; e[2] = e[3]; e[3] = e[4]; e[4] = e[5]; e[5] = e[6]; e[6] = e[7]; e[7] = 0u; }
    }
    val = f16key_val(mine >> 16); idx = (int)(mine & 127u);
}
constexpr int PEER_T = 4;
constexpr int PEER_NSL = 16;
constexpr int PEER_SLSH = 10;
constexpr int PEER_WSC = 1024 + 256 + PEER_T * (1024 + 2048);
__device__ __forceinline__ void peer_select16(const _Float16* SCp, int lane, LAS unsigned* sel) {
    typedef short s16x2_t __attribute__((ext_vector_type(2)));
    const int p = lane & 3;
    unsigned D[16];
    { const u32x4* src = (const u32x4*)SCp + 4 * lane;
#pragma unroll
      for (int q = 0; q < 4; ++q) { const u32x4 v = src[q]; D[4 * q] = v.x; D[4 * q + 1] = v.y; D[4 * q + 2] = v.z; D[4 * q + 3] = v.w; } }
#pragma unroll
    for (int i = 0; i < 16; ++i) { const s16x2_t h = __builtin_bit_cast(s16x2_t, D[i]); const s16x2_t sh = {15, 15};
        D[i] ^= (__builtin_bit_cast(unsigned, h >> sh) | 0x80008000u); }
    unsigned X[16];
#pragma unroll
    for (int j = 0; j < 16; ++j) X[j] = __builtin_amdgcn_perm(D[8 + (j >> 1)], D[j >> 1], (j & 1) ? 0x07060302u : 0x05040100u);
    bt16(X);
    unsigned A = ~0u, G = 0u; int cntG = 0;
#pragma unroll
    for (int b = 15; b >= 0; --b) {
        const unsigned t = A & X[b]; int n = (int)__builtin_popcount(t);
        n += dppi<0xB1>(n); n += dppi<0x4E>(n);
        const bool take = cntG + n >= 16;
        A = take ? t : (A ^ t); G = take ? G : (G | t); cntG = take ? cntG : cntG + n;
    }
    { const int tc = (int)__builtin_popcount(A);
      const int t0 = dppi<0x00>(tc), t1 = dppi<0x55>(tc), t2 = dppi<0xAA>(tc);
      const int ex = (p > 0 ? t0 : 0) + (p > 1 ? t1 : 0) + (p > 2 ? t2 : 0);
      int k = 16 - cntG - ex; k = k < 0 ? 0 : (k > tc ? tc : k);
      while ((int)__builtin_popcount(A) > k) A &= ~(0x80000000u >> __builtin_clz(A)); }
    unsigned S = G | A;
    { const int sc = (int)__builtin_popcount(S);
      const int t0 = dppi<0x00>(sc), t1 = dppi<0x55>(sc), t2 = dppi<0xAA>(sc);
      int pos = (lane >> 2) * 16 + (p > 0 ? t0 : 0) + (p > 1 ? t1 : 0) + (p > 2 ? t2 : 0);
      while (S) { const int m = __builtin_ctz(S); S &= S - 1u; sel[pos] = (unsigned)(32 * p + m); ++pos; } }
}
__device__ __forceinline__ void peer_route(Frame& F, int tok, LAS float* wsc, LAS float* tls, int& cvec) {
    const int lane = F.lane, gq = lane >> 4, li = lane & 15;
    const float* ffn_norm = F.in[7];
    const u16* xrow = (const u16*)(F.ws + WS_X1B) + (size_t)tok * DMODEL;
    const _Float16* SCp = (const _Float16*)(F.ws + WS_SC) + (size_t)tok * 2048;
    f32x4 xv[4]; float ss = 0.f;
    { const u32x4 r0 = *(const u32x4*)(xrow + 16 * lane), r1 = *(const u32x4*)(xrow + 16 * lane + 8);
      const unsigned w[8] = {r0.x, r0.y, r0.z, r0.w, r1.x, r1.y, r1.z, r1.w};
#pragma unroll
      for (int q = 0; q < 4; ++q) { xv[q][0] = bf2f(w[2 * q] & 0xffffu); xv[q][1] = bf2f(w[2 * q] >> 16); xv[q][2] = bf2f(w[2 * q + 1] & 0xffffu); xv[q][3] = bf2f(w[2 * q + 1] >> 16); } }
#pragma unroll
    for (int q = 0; q < 4; ++q) ss += (xv[q][0] * xv[q][0] + xv[q][1] * xv[q][1]) + (xv[q][2] * xv[q][2] + xv[q][3] * xv[q][3]);
    const float rstd2 = 1.0f / sqrtf(wave_sum(ss) * (1.f / DMODEL) + EPS);
#pragma unroll
    for (int q = 0; q < 4; ++q) { const f32x4 g = *(const f32x4*)(ffn_norm + 16 * lane + 4 * q);
        ((LAS unsigned*)tls)[256 + (2 * q) * 64 + lane] = cvt_pk_bf16(xv[q][0] * rstd2 * g[0], xv[q][1] * rstd2 * g[1]); ((LAS unsigned*)tls)[256 + (2 * q + 1) * 64 + lane] = cvt_pk_bf16(xv[q][2] * rstd2 * g[2], xv[q][3] * rstd2 * g[3]); }
    int ex[2]; float gt[2]; unsigned exk[2];
    LAS float* aval = wsc; LAS int* aidx = (LAS int*)(wsc + 64); LAS float* bval = wsc + 128; LAS int* bidx = (LAS int*)(wsc + 192);
    const int ci2 = li <= 6 ? 1 : (li <= 10 ? 2 : (li <= 13 ? 3 : 4)), cj2 = li <= 6 ? li + 1 : (li <= 10 ? li - 6 : (li <= 13 ? li - 10 : li - 13));
    LAS unsigned* sel = (LAS unsigned*)tls;
    peer_select16(SCp, lane, sel);
    LDS_WAIT();
#pragma unroll
    for (int R = 0; R < 2; ++R) {
        const int hh = 4 * R + gq;
        const int rb16 = gq * 16;
        float av, bv; int ai, bi;
        {
            const int ia = (int)sel[(2 * hh) * 16 + li], ib = (int)sel[(2 * hh + 1) * 16 + li];
            const unsigned sa = ((const u16*)SCp)[(2 * hh) * 128 + ia], sb = ((const u16*)SCp)[(2 * hh + 1) * 128 + ib];
            const unsigned ka = (f16key(sa) << 16) | (unsigned)ia, kb = (f16key(sb) << 16) | (unsigned)ib;
            int ra_ = 0, rb_ = 0;
#define PEER_ROT(sft) { const unsigned xa = (unsigned)dppi<0x120 + sft>((int)ka), xb = (unsigned)dppi<0x120 + sft>((int)kb); ra_ += xa > ka ? 1 : 0; rb_ += xb > kb ? 1 : 0; }
            PEER_ROT(1) PEER_ROT(2) PEER_ROT(3) PEER_ROT(4) PEER_ROT(5) PEER_ROT(6) PEER_ROT(7) PEER_ROT(8) PEER_ROT(9) PEER_ROT(10) PEER_ROT(11) PEER_ROT(12) PEER_ROT(13) PEER_ROT(14) PEER_ROT(15)
#undef PEER_ROT
            aval[rb16 + ra_] = f16key_val(ka >> 16); aidx[rb16 + ra_] = ia; bval[rb16 + rb_] = f16key_val(kb >> 16); bidx[rb16 + rb_] = ib;
            av = aval[lane]; ai = aidx[lane]; bv = bval[lane]; bi = bidx[lane];
        }
        const float a0 = aval[rb16], b0 = bval[rb16], a2 = aval[rb16 + ci2], b2 = bval[rb16 + cj2], a3 = aval[rb16 + ((5 + li) & 15)], b1 = bval[rb16 + 1];
        unsigned e0 = (f32key(a0 + bv) & ~63u) | (unsigned)li;
        unsigned e1 = li >= 1 ? ((f32key(av + b0) & ~63u) | (unsigned)(16 + li)) : 0u;
        unsigned e2 = (f32key(a2 + b2) & ~63u) | (unsigned)(32 + li);
        unsigned e3 = li <= 2 ? ((f32key(a3 + b1) & ~63u) | (unsigned)(48 + li)) : 0u;
        CE(e0, e1); CE(e2, e3); CE(e0, e2); CE(e1, e3); CE(e1, e2);
        unsigned mine = 0u;
#pragma unroll
        for (int r = 0; r < 16; ++r) {
            const unsigned M = row16_maxu(e0);
            if (li == r) mine = M;
            if (e0 == M) { e0 = e1; e1 = e2; e2 = e3; e3 = 0u; }
        }
        const int sub = (int)((mine >> 4) & 3u), sl = (int)(mine & 15u);
        const int si2 = sl <= 6 ? 1 : (sl <= 10 ? 2 : (sl <= 13 ? 3 : 4)), sj2 = sl <= 6 ? sl + 1 : (sl <= 10 ? sl - 6 : (sl <= 13 ? sl - 10 : sl - 13));
        const int wi = sub == 0 ? 0 : (sub == 1 ? sl : (sub == 2 ? si2 : 5 + sl)), wj = sub == 0 ? sl : (sub == 1 ? 0 : (sub == 2 ? sj2 : 1));
        const float sm = aval[rb16 + wi] + bval[rb16 + wj]; ex[R] = aidx[rb16 + wi] * 128 + bidx[rb16 + wj];
        const unsigned kuv = ((const unsigned*)(F.ws + WS_KUV))[ex[R]];
        const float mx = row16_max(sm);
        const float ee = __expf(rstd2 * (sm - mx));
        gt[R] = ldexpf(ee / row16_sum(ee), 64 - (int)((kuv >> 8) & 0xffu));
        exk[R] = (unsigned)ex[R] * 768u | ((kuv & 0xffu) << 24);
    }
    LAS int* cnt = (LAS int*)wsc; LAS int* offs = (LAS int*)(wsc + 64);
    LAS int* sex = (LAS int*)tls; LAS float* sgt = tls + 128;
    cnt[lane] = 0;
    const int s0 = ex[0] >> PEER_SLSH, s1 = ex[1] >> PEER_SLSH;
    const int r0 = __hip_atomic_fetch_add(&cnt[s0], 1, __ATOMIC_RELAXED, __HIP_MEMORY_SCOPE_WORKGROUP);
    const int r1 = __hip_atomic_fetch_add(&cnt[s1], 1, __ATOMIC_RELAXED, __HIP_MEMORY_SCOPE_WORKGROUP);
    const int c0 = cnt[lane]; int c = c0;
#pragma unroll
    for (int o = 1; o < 64; o <<= 1) { const int t = __shfl_up(c, o, 64); if (lane >= o) c += t; }
    offs[lane] = c - c0;
    cvec = c;
    const int p0 = offs[s0] + r0, p1 = offs[s1] + r1;
    sex[p0] = (int)exk[0]; sgt[p0] = gt[0]; sex[p1] = (int)exk[1]; sgt[p1] = gt[1];
}
typedef unsigned v6u32 __attribute__((ext_vector_type(6)));
typedef __bf16 v32bf __attribute__((ext_vector_type(32)));
typedef float v32f __attribute__((ext_vector_type(32)));
__device__ __forceinline__ void peer_batch(const unsigned char* U6, const unsigned char* V6, int lane, int b, const LAS float* tls, float (&acc)[16]) {
    const LAS unsigned* sex = (const LAS unsigned*)tls; const LAS float* sgt = tls + 128;
    typedef unsigned v2u32_t __attribute__((ext_vector_type(2)));
    typedef unsigned v3u32_t __attribute__((ext_vector_type(3)));
    const __amdgpu_buffer_rsrc_t ru = __builtin_amdgcn_make_buffer_rsrc((void*)U6, 0, 0x7fffffff, 0x00020000);
    const __amdgpu_buffer_rsrc_t rv = __builtin_amdgcn_make_buffer_rsrc((void*)V6, 0, 0x7fffffff, 0x00020000);
    const int lofs = 12 * lane;
    v6u32 pku[4], pkv[4];
#pragma unroll
    for (int jj = 0; jj < 4; ++jj) {
        const int e0 = (int)((unsigned)__builtin_amdgcn_readfirstlane((int)sex[8 * b + 2 * jj]) & 0xffffffu), e1 = (int)((unsigned)__builtin_amdgcn_readfirstlane((int)sex[8 * b + 2 * jj + 1]) & 0xffffffu);
        { const v3u32_t a = __builtin_amdgcn_raw_buffer_load_b96(ru, lofs, e0, 0); const unsigned bx = __builtin_amdgcn_raw_buffer_load_b32(ru, lofs, e1, 0); const v2u32_t byz = __builtin_amdgcn_raw_buffer_load_b64(ru, lofs + 4, e1, 0);
          pku[jj] = (v6u32){a.x, a.y, a.z, bx, byz.x, byz.y}; }
        { const v3u32_t a = __builtin_amdgcn_raw_buffer_load_b96(rv, lofs, e0, 0); const unsigned bx = __builtin_amdgcn_raw_buffer_load_b32(rv, lofs, e1, 0); const v2u32_t byz = __builtin_amdgcn_raw_buffer_load_b64(rv, lofs + 4, e1, 0);
          pkv[jj] = (v6u32){a.x, a.y, a.z, bx, byz.x, byz.y}; }
    }
    unsigned hp[8];
#pragma unroll
    for (int k = 0; k < 8; ++k) hp[k] = ((const LAS unsigned*)tls)[256 + k * 64 + lane];
    float d[8];
#pragma unroll
    for (int jj = 0; jj < 4; ++jj) {
        const v32bf r = __builtin_amdgcn_cvt_scalef32_pk32_bf16_fp6(pku[jj], 1.0f);
        float s0 = 0.f, s1 = 0.f;
#pragma unroll
        for (int k = 0; k < 8; ++k) {
            const bf16x2v x0 = {r[2 * k], r[2 * k + 1]}, x1 = {r[16 + 2 * k], r[17 + 2 * k]};
            s0 = __builtin_amdgcn_fdot2_f32_bf16(x0, __builtin_bit_cast(bf16x2v, hp[k]), s0, false);
            s1 = __builtin_amdgcn_fdot2_f32_bf16(x1, __builtin_bit_cast(bf16x2v, hp[k]), s1, false);
        }
        d[2 * jj] = s0; d[2 * jj + 1] = s1;
    }
    float t4[4], t2[2], t1;
    { const bool up = lane & 4;
#pragma unroll
      for (int k = 0; k < 4; ++k) { const float keep = up ? d[4 + k] : d[k], send = up ? d[k] : d[4 + k]; t4[k] = keep + dppf<0x141>(send); } }
    { const bool up = lane & 1;
#pragma unroll
      for (int k = 0; k < 2; ++k) { const float keep = up ? t4[2 + k] : t4[k], send = up ? t4[k] : t4[2 + k]; t2[k] = keep + dppf<0xB1>(send); } }
    { const bool up = lane & 2; const float keep = up ? t2[1] : t2[0], send = up ? t2[0] : t2[1]; t1 = keep + dppf<0x4E>(send); }
    t1 += dppf<0x128>(t1);
    { auto r = __builtin_amdgcn_permlane16_swap(__float_as_uint(t1), __float_as_uint(t1), false, false); const unsigned r0 = r[0], r1 = r[1]; t1 = __uint_as_float(r0) + __uint_as_float(r1); }
    { auto r = __builtin_amdgcn_permlane32_swap(__float_as_uint(t1), __float_as_uint(t1), false, false); const unsigned r0 = r[0], r1 = r[1]; t1 = __uint_as_float(r0) + __uint_as_float(r1); }
    const int myj = 4 * ((lane >> 2) & 1) + 2 * (lane & 1) + ((lane >> 1) & 1);
    const float g = sgt[8 * b + myj];
    const int ku = (int)(sex[8 * b + myj] >> 24) - 64;
    const float coef = g * gelu_erf(ldexpf(t1, -ku));
#pragma unroll
    for (int jj = 0; jj < 4; ++jj) {
        const int j0 = 2 * jj, j1 = 2 * jj + 1;
        const int src0 = 4 * (j0 >> 2) + ((j0 >> 1) & 1) + 2 * (j0 & 1), src1 = 4 * (j1 >> 2) + ((j1 >> 1) & 1) + 2 * (j1 & 1);
        const float c0 = __builtin_bit_cast(float, __builtin_amdgcn_readlane(__builtin_bit_cast(int, coef), src0));
        const float c1 = __builtin_bit_cast(float, __builtin_amdgcn_readlane(__builtin_bit_cast(int, coef), src1));
        const v32f r = __builtin_amdgcn_cvt_scalef32_pk32_f32_fp6(pkv[jj], 1.0f);
#pragma unroll
        for (int i = 0; i < 16; ++i) { acc[i] = __builtin_fmaf(c0, r[i], acc[i]); acc[i] = __builtin_fmaf(c1, r[16 + i], acc[i]); }
        __builtin_amdgcn_sched_barrier(0);
    }
}
__device__ __forceinline__ void peer_finish(Frame& F, int tok, const float (&acc)[16]) {
    const int lane = F.lane; const float* fin_norm = F.in[12];
    float* orow = F.out + (size_t)tok * DMODEL; const u16* xrow = (const u16*)(F.ws + WS_X1B) + (size_t)tok * DMODEL;
    f32x4 o[4]; float s2 = 0.f;
    { const u32x4 r0 = *(const u32x4*)(xrow + 16 * lane), r1 = *(const u32x4*)(xrow + 16 * lane + 8);
      const unsigned w[8] = {r0.x, r0.y, r0.z, r0.w, r1.x, r1.y, r1.z, r1.w};
#pragma unroll
      for (int q = 0; q < 4; ++q) { o[q][0] = bf2f(w[2 * q] & 0xffffu); o[q][1] = bf2f(w[2 * q] >> 16); o[q][2] = bf2f(w[2 * q + 1] & 0xffffu); o[q][3] = bf2f(w[2 * q + 1] >> 16); } }
#pragma unroll
    for (int q = 0; q < 4; ++q)
#pragma unroll
        for (int j = 0; j < 4; ++j) { o[q][j] += acc[4 * q + j]; s2 += o[q][j] * o[q][j]; }
    const float rs = 1.0f / sqrtf(wave_sum(s2) * (1.f / DMODEL) + EPS);
#pragma unroll
    for (int q = 0; q < 4; ++q) { const f32x4 fn = *(const f32x4*)(fin_norm + 16 * lane + 4 * q); f32x4 r;
#pragma unroll
        for (int j = 0; j < 4; ++j) r[j] = o[q][j] * rs * fn[j];
        *(f32x4*)(orow + 16 * lane + 4 * q) = r; }
}
constexpr int CW_PQ = 7680;
__device__ __forceinline__ unsigned peer_group(Frame& F, int g, LAS float* wsc, unsigned* q) {
    const unsigned char* U8 = (const unsigned char*)(F.ws + WS_U); const unsigned char* V8 = (const unsigned char*)(F.ws + WS_V);
    int cvec[PEER_T]; float acc[PEER_T][16]; int nb[PEER_T];
#pragma unroll
    for (int t = 0; t < PEER_T; ++t) { peer_route(F, g * PEER_T + t, wsc, wsc + 320 + t * 768, cvec[t]); nb[t] = 0;
#pragma unroll
        for (int i = 0; i < 16; ++i) acc[t][i] = 0.f; }
#pragma unroll 1
    for (int s = 0; s < PEER_NSL; ++s) {
#pragma unroll
        for (int t = 0; t < PEER_T; ++t) {
            const int cs = __builtin_amdgcn_readlane(cvec[t], s);
            while (8 * (nb[t] + 1) <= cs) { peer_batch(U8, V8, F.lane, nb[t], wsc + 320 + t * 768, acc[t]); ++nb[t]; }
        }
    }
    unsigned tk = 0u;
    if (q) { if (F.lane == 0) tk = xb_add(q, 1u); }
#pragma unroll
    for (int t = 0; t < PEER_T; ++t) peer_finish(F, g * PEER_T + t, acc[t]);
    return (unsigned)__builtin_amdgcn_readfirstlane((int)tk);
}

#ifndef MK_N_LAUNCHES
#define MK_N_LAUNCHES 1
#endif
constexpr int N_PHASES = 9;
constexpr int N_LAUNCHES = MK_N_LAUNCHES;
constexpr int CW_BAR = 4096;

struct Args { const float* in[13]; float* out; unsigned char* ws; int ph_lo, ph_hi, li, pad; };

__global__ void __launch_bounds__(NWAVES * 64, 2) mk_fwd(Args args) {
    extern __shared__ __attribute__((aligned(16))) unsigned char lds[];
    Frame F;
    F.lds = (LAS unsigned char*)lds; F.ldsg = lds;
    F.tid = threadIdx.x; F.lane = F.tid & 63; F.wave = __builtin_amdgcn_readfirstlane(F.tid >> 6);
    F.G = gridDim.x; { const int bx = blockIdx.x; F.vcu = (F.G % 8 == 0) ? (bx % 8) * (F.G / 8) + bx / 8 : bx; }
#pragma unroll
    for (int i = 0; i < 13; ++i) F.in[i] = args.in[i];
    F.out = args.out; F.ws = args.ws;
    volatile LAS unsigned* MISC = (volatile LAS unsigned*)(F.lds + MISC_OFF);
    for (int u = F.tid; u < (LDS_BYTES - LDSCTL_OFF) / 4; u += NWAVES * 64) ((LAS unsigned*)(F.lds + LDSCTL_OFF))[u] = 0u;
    __syncthreads();
    unsigned* ctl = (unsigned*)(F.ws + WS_CTL);
    XcdBarrier bar; bar.bar = ctl + CW_BAR; bar.x = 0; bar.st = nullptr;
    if (N_LAUNCHES == 1) bar = xcd_barrier_post(ctl + CW_BAR, MISC + 8);
    const int lo = args.ph_lo, hi = args.ph_hi;
#ifndef PH_MASK
#define PH_MASK 0x1FF
#endif
#define IN(k) (((PH_MASK >> (k)) & 1) && lo <= (k) && (k) < hi)
#define SEAM(k) do { if (IN(k) && IN((k) + 1)) xcd_barrier(bar); } while (0)

    if (IN(0)) { p0_prologue(F); }
    SEAM(0);
    if (IN(1)) {
        pg8::Desc S{}; S.A0 = (const u16*)(F.ws + WS_XB); S.B0 = (const u16*)(F.ws + WS_WIN); S.A1 = S.A0; S.B1 = S.B0;
        S.K = 1024; S.nM = NTOK / 256; S.nN = N1PAD / 256; S.nsub = 1; S.G = F.G; S.c = (int)blockIdx.x; S.mode = pg8::M_PROJ; S.ws = F.ws; S.xin = nullptr; S.out = nullptr;
        pg8::gemm_phase(F.lds + RING_OFF, S);
    }
    SEAM(1);
    if (IN(2)) {
        if (F.G == 256) {
            const int xcd = F.vcu >> 5, wi = F.vcu & 31, b = xcd >> 1, half = xcd & 1;
#define IDX_GRP_A(k) (b * 1024 + (127 - (((k) * 64 + half * 32 + wi) >> 3)) * 8 + (((k) * 64 + half * 32 + wi) & 7))
            IdxPre P; idx_prefetch(F, IDX_GRP_A(0), P);
            for (int k = 0; k < 16; ++k) indexer_group(F, IDX_GRP_A(k), IDX_GRP_A(k < 15 ? k + 1 : k), P);
#undef IDX_GRP_A
        } else {
#define IDX_GRP_B(i) (((i) & 31) >> 3) * 1024 + (127 - ((i) >> 5)) * 8 + ((i) & 7)
            if (F.vcu < 4096) { IdxPre P; idx_prefetch(F, IDX_GRP_B(F.vcu), P);
                for (int i = F.vcu; i < 4096; i += F.G) indexer_group(F, IDX_GRP_B(i), IDX_GRP_B(i + F.G < 4096 ? i + F.G : i), P); }
#undef IDX_GRP_B
        }
        __syncthreads();
        if (F.vcu < 2048) { KvIn kin; ret_kv_load(F, F.vcu, kin);
            for (int it = F.vcu; it < 2048; it += F.G) ret_kv_item(F, it, kin, it + F.G < 2048 ? it + F.G : -1); }
        __syncthreads();
    }
    SEAM(2);
    if (IN(3)) { ret_scan(F); }
    SEAM(3);
    if (IN(4)) {
        if (F.tid < 64) { const int e = F.tid >> 2, j = F.tid & 3; ((LAS float*)(F.lds + attn_body::LDS_TBL))[F.tid] = ((e >> j) & 1) ? 0.f : -INFINITY; }
        __syncthreads();
        const attn_body::bf16* Qp = (const attn_body::bf16*)(F.ws + WS_DQ); const attn_body::bf16* Kp = (const attn_body::bf16*)(F.ws + WS_DK); const attn_body::bf16* Vp = (const attn_body::bf16*)(F.ws + WS_DV);
        attn_body::bf16* Op = (attn_body::bf16*)(F.ws + WS_YDSA);
        const unsigned long long* BMp = (const unsigned long long*)((unsigned char*)F.out + OUT_BM);
        for (int v = F.vcu; v < 256; v += F.G) {
            const int s = v & 7, bh = v >> 3;
#pragma unroll 1
            for (int i = 0; i < 4; ++i) { const int qb = (i == 0) ? s : (i == 1) ? 15 - s : (i == 2) ? 16 + s : 31 - s;
                attn_body::attn_unit<8>(bh >> 3, bh & 7, qb, Qp, Kp, Vp, Op, BMp, (char*)lds + RING_OFF); }
        }
        __syncthreads();
        if (F.vcu < 2048) { OutIn oin; ret_out_load(F, F.vcu, oin);
            for (int it = F.vcu; it < 2048; it += F.G) ret_out_item(F, it, oin, it + F.G < 2048 ? it + F.G : -1); }
        __syncthreads();
    }
    SEAM(4);
    if (IN(5)) {
        pg8::Desc S{}; S.A0 = (const u16*)(F.ws + WS_YRET); S.B0 = (const u16*)(F.ws + WS_WRO); S.A1 = (const u16*)(F.ws + WS_YDSA); S.B1 = (const u16*)(F.ws + WS_WDO);
        S.K = 512; S.nM = NTOK / 256; S.nN = 4; S.nsub = 2; S.G = F.G; S.c = (int)blockIdx.x; S.mode = pg8::M_MERGE; S.ws = F.ws; S.xin = nullptr; S.out = nullptr;
        pg8::gemm_phase(F.lds + RING_OFF, S);
    }
    SEAM(5);
    if (IN(6)) {
        pg8::Desc S{}; S.A0 = (const u16*)(F.ws + WS_MERGED); S.B0 = (const u16*)(F.ws + WS_WOUT); S.A1 = S.A0; S.B1 = S.B0;
        S.K = 1024; S.nM = NTOK / 256; S.nN = 4; S.nsub = 1; S.G = F.G; S.c = (int)blockIdx.x; S.mode = pg8::M_OUT; S.ws = F.ws; S.xin = F.in[0]; S.out = F.out;
        pg8::gemm_phase(F.lds + RING_OFF, S);
    }
    SEAM(6);
    if (IN(7)) {
        pg8::Desc S{}; S.A0 = (const u16*)(F.ws + WS_X1B); S.B0 = (const u16*)(F.ws + WS_WSC); S.A1 = S.A0; S.B1 = S.B0;
        S.K = 1024; S.nM = NTOK / 256; S.nN = 8; S.nsub = 1; S.G = F.G; S.c = (int)blockIdx.x; S.mode = pg8::M_SCORE; S.ws = F.ws; S.xin = nullptr; S.out = nullptr;
        pg8::gemm_phase(F.lds + RING_OFF, S);
    }
    SEAM(7);
    if (IN(8)) {
        LAS float* wsc = (LAS float*)(F.lds + F.wave * PEER_WSC);
        const int gw = F.vcu * NWAVES + F.wave, NGW = F.G * NWAVES;
        if (N_LAUNCHES == 1 && NGW <= NTOK / PEER_T) {
            unsigned* q = ctl + CW_PQ;
            int g = gw;
            while (g < NTOK / PEER_T) { const unsigned tk = peer_group(F, g, wsc, q); g = NGW + (int)tk; }
        } else {
            for (int g = gw; g < NTOK / PEER_T; g += NGW) (void)peer_group(F, g, wsc, nullptr);
        }
    }
#undef IN
#undef SEAM
}

extern "C" void kernel_launch(void* const* d_in, const int* in_sizes, int n_in, void* d_out, int out_size, void* d_ws, size_t ws_size, hipStream_t stream) {
    static int grid = 0;
    if (grid == 0) {
        if (n_in != 13 || in_sizes[0] != NTOK * DMODEL || out_size != NTOK * DMODEL || ws_size < WS_END) {
            fprintf(stderr, "kernel_launch: unexpected shapes (n_in %d, in0 %d, out %d, ws %zu)\n", n_in, n_in > 0 ? in_sizes[0] : -1, out_size, ws_size); grid = -1; return; }
        int dev = 0, cus = 0, per_cu = 0;
        if (hipGetDevice(&dev) != hipSuccess || hipDeviceGetAttribute(&cus, hipDeviceAttributeMultiprocessorCount, dev) != hipSuccess) { grid = -1; return; }
        if (hipFuncSetAttribute((const void*)mk_fwd, hipFuncAttributeMaxDynamicSharedMemorySize, LDS_BYTES) != hipSuccess) { fprintf(stderr, "kernel_launch: hipFuncSetAttribute failed\n"); grid = -1; return; }
        if (hipOccupancyMaxActiveBlocksPerMultiprocessor(&per_cu, (const void*)mk_fwd, NWAVES * 64, LDS_BYTES) != hipSuccess || per_cu < 1) {
            fprintf(stderr, "kernel_launch: occupancy query reports %d workgroups per CU\n", per_cu); }
        (void)hipGetLastError();
        grid = cus;
    }
    if (grid < 0) return;
    if (hipMemsetAsync((char*)d_ws + WS_CTL, 0, CTL_ZERO_BYTES, stream) != hipSuccess) return;
    Args a{};
    for (int i = 0; i < 13; ++i) a.in[i] = (const float*)d_in[i];
    a.out = (float*)d_out; a.ws = (unsigned char*)d_ws;
    for (int li = 0; li < N_LAUNCHES; ++li) {
        a.ph_lo = (N_LAUNCHES == 1) ? 0 : li; a.ph_hi = (N_LAUNCHES == 1) ? N_PHASES : li + 1; a.li = li; a.pad = 0;
        hipLaunchKernelGGL(mk_fwd, dim3(grid), dim3(NWAVES * 64), LDS_BYTES, stream, a);
    }
}
```

```cpp
#include <hip/hip_runtime.h>
#include <hip/hip_bf16.h>
#include <cstdio>
#include <cstdint>
#include <cmath>

#define LAS __attribute__((address_space(3)))
#define GAS __attribute__((address_space(1)))
typedef unsigned short u16;
typedef short bf16x8 __attribute__((ext_vector_type(8)));
typedef _Float16 f16x8 __attribute__((ext_vector_type(8)));
typedef _Float16 f16x4 __attribute__((ext_vector_type(4)));
typedef float f32x2 __attribute__((ext_vector_type(2)));
typedef float f32x4 __attribute__((ext_vector_type(4)));
typedef float f32x16 __attribute__((ext_vector_type(16)));
typedef unsigned u32x2 __attribute__((ext_vector_type(2)));
typedef unsigned u32x4 __attribute__((ext_vector_type(4)));
typedef short s16x4 __attribute__((ext_vector_type(4)));
typedef unsigned short u16x2 __attribute__((ext_vector_type(2)));
typedef __bf16 bf16x2v __attribute__((ext_vector_type(2)));

constexpr int NTOK = 32768, SEQ = 8192, NBATCH = 4, DMODEL = 1024;
constexpr int D_IN = 5444;
constexpr int N1PAD = 5632;
constexpr float EPS = 1e-6f;
constexpr float C2 = 0.125f * 1.4426950408889634f;
constexpr int NWAVES = 8;

constexpr size_t MiB = 1u << 20;
constexpr size_t WS_CTL = 0, CTL_ZERO_BYTES = 32768;
constexpr size_t WS_WIN = 1 * MiB;
constexpr size_t WS_WRO = 12 * MiB;
constexpr size_t WS_WDO = 13 * MiB;
constexpr size_t WS_WOUT = 14 * MiB;
constexpr size_t WS_WSC = 16 * MiB;
constexpr size_t WS_U = 20 * MiB;
constexpr size_t WS_V = 52 * MiB;
constexpr size_t WS_TABA = 84 * MiB;
constexpr size_t WS_TABB = 86 * MiB;
constexpr size_t WS_IW = 87 * MiB;
constexpr size_t WS_KUV = 87 * MiB + 768 * 1024;
constexpr size_t WS_RSTD = 87 * MiB + 896 * 1024;
constexpr size_t WS_XB = 428 * MiB;
constexpr size_t WS_YRET = 88 * MiB;
constexpr size_t WS_YDSA = 120 * MiB;
constexpr size_t WS_RQ = 152 * MiB;
constexpr size_t WS_RK = 168 * MiB;
constexpr size_t WS_RV = 184 * MiB;
constexpr size_t WS_RG = 216 * MiB;
constexpr size_t WS_DQ = 248 * MiB;
constexpr size_t WS_DK = 280 * MiB;
constexpr size_t WS_DV = 312 * MiB;
constexpr size_t WS_IQ = 344 * MiB;
constexpr size_t WS_IK = 360 * MiB;
constexpr size_t WS_GATES = 364 * MiB;
constexpr size_t WS_MERGED = 152 * MiB;
constexpr size_t WS_X1B = 216 * MiB;
constexpr size_t WS_SC = 364 * MiB;
constexpr size_t WS_END = 492 * MiB;
__host__ __device__ __forceinline__ int sc_pos(int c) { return 512 * ((c >> 3) & 3) + 8 * (c >> 5) + (c & 7); }
constexpr size_t OUT_KV = 0, OUT_BM = 64 * MiB;

#define RLX_AGENT __ATOMIC_RELAXED, __HIP_MEMORY_SCOPE_AGENT
#define LDS_WAIT() asm volatile("s_waitcnt lgkmcnt(0)" ::: "memory")
#define VM_WAIT() asm volatile("s_waitcnt vmcnt(0)" ::: "memory")
__device__ __forceinline__ unsigned cvt_pk_bf16(float lo, float hi) { unsigned r; asm volatile("v_cvt_pk_bf16_f32 %0, %1, %2" : "=v"(r) : "v"(lo), "v"(hi)); return r; }
__device__ __forceinline__ unsigned f2bf(float f) { unsigned u = __builtin_bit_cast(unsigned, f); return (u + 0x7fffu + ((u >> 16) & 1u)) >> 16; }
__device__ __forceinline__ float bf2f(unsigned b) { return __builtin_bit_cast(float, b << 16); }
__device__ __forceinline__ unsigned pk_f16(float lo, float hi) { _Float16 a = (_Float16)lo, b = (_Float16)hi; return (unsigned)__builtin_bit_cast(u16, a) | ((unsigned)__builtin_bit_cast(u16, b) << 16); }
template <int CTRL> __device__ __forceinline__ int dppi(int x) { return __builtin_amdgcn_mov_dpp(x, CTRL, 0xf, 0xf, true); }
template <int CTRL> __device__ __forceinline__ float dppf(float x) { return __builtin_bit_cast(float, __builtin_amdgcn_mov_dpp(__builtin_bit_cast(int, x), CTRL, 0xf, 0xf, true)); }
__device__ __forceinline__ float row16_sum(float v) { v += dppf<0xB1>(v); v += dppf<0x4E>(v); v += dppf<0x141>(v); v += dppf<0x128>(v); return v; }
__device__ __forceinline__ float row16_max(float v) { v = fmaxf(v, dppf<0xB1>(v)); v = fmaxf(v, dppf<0x4E>(v)); v = fmaxf(v, dppf<0x141>(v)); v = fmaxf(v, dppf<0x128>(v)); return v; }
__device__ __forceinline__ unsigned row16_maxu(unsigned v) {
    unsigned t;
    t = (unsigned)dppi<0xB1>((int)v); v = v > t ? v : t; t = (unsigned)dppi<0x4E>((int)v); v = v > t ? v : t;
    t = (unsigned)dppi<0x141>((int)v); v = v > t ? v : t; t = (unsigned)dppi<0x128>((int)v); v = v > t ? v : t; return v; }
__device__ __forceinline__ float wave_sum(float v) {
    v = row16_sum(v);
    { auto r = __builtin_amdgcn_permlane16_swap(__float_as_uint(v), __float_as_uint(v), false, false); const unsigned r0 = r[0], r1 = r[1]; v = __uint_as_float(r0) + __uint_as_float(r1); }
    { auto r = __builtin_amdgcn_permlane32_swap(__float_as_uint(v), __float_as_uint(v), false, false); const unsigned r0 = r[0], r1 = r[1]; v = __uint_as_float(r0) + __uint_as_float(r1); }
    return v; }
__device__ __forceinline__ int wave_sum_i(int v) {
    v += dppi<0xB1>(v); v += dppi<0x4E>(v); v += dppi<0x141>(v); v += dppi<0x128>(v);
    { auto r = __builtin_amdgcn_permlane16_swap((unsigned)v, (unsigned)v, false, false); const unsigned r0 = r[0], r1 = r[1]; v = (int)(r0 + r1); }
    { auto r = __builtin_amdgcn_permlane32_swap((unsigned)v, (unsigned)v, false, false); const unsigned r0 = r[0], r1 = r[1]; v = (int)(r0 + r1); }
    return v; }
__device__ __forceinline__ float wave_max(float v) {
    v = row16_max(v);
    { auto r = __builtin_amdgcn_permlane16_swap(__float_as_uint(v), __float_as_uint(v), false, false); const unsigned r0 = r[0], r1 = r[1]; v = fmaxf(__uint_as_float(r0), __uint_as_float(r1)); }
    { auto r = __builtin_amdgcn_permlane32_swap(__float_as_uint(v), __float_as_uint(v), false, false); const unsigned r0 = r[0], r1 = r[1]; v = fmaxf(__uint_as_float(r0), __uint_as_float(r1)); }
    return v; }
struct __attribute__((packed, aligned(4))) U3 { unsigned x, y, z; };
__device__ __forceinline__ unsigned fp6_code(float x) {
    const float a = fabsf(x);
    const unsigned bits = __float_as_uint(a);
    const unsigned rn = (bits + 0x7FFFFu + ((bits >> 20) & 1u)) >> 20;
    const int cn = (int)rn - 1008;
    const int cs = (int)__builtin_rintf(a * 8.0f);
    int c = a >= 1.0f ? cn : cs; c = c > 31 ? 31 : c;
    return (unsigned)c | (x < 0.f ? 32u : 0u);
}
__device__ __forceinline__ float sigmoidf_(float x) { return __builtin_amdgcn_rcpf(1.0f + __builtin_amdgcn_exp2f(-1.4426950408889634f * x)); }
__device__ __forceinline__ float gelu_erf(float v) {
    const float av = fabsf(v), t = __builtin_amdgcn_rcpf(av * 0.2316418882f + 1.0f);
    float q = t * 0.5307027145f + (-0.7265760135f); q = q * t + 0.7107068705f; q = q * t + (-0.142248368f); q = q * t + 0.127414796f; q = q * t;
    const float e = __builtin_amdgcn_exp2f((v * v) * (-0.72134752044f));
    const float m = v * (q * e);
    return v < 0.f ? m : v - m;
}

namespace pg8 {
typedef u16 bf16_t;
constexpr int BM = 256, BK = 64, HALF = 128, HTB = HALF * BK * 2, STAGE_BYTES = 8 * HTB, NXCD = 8, WGM = 8;
__host__ __device__ __forceinline__ int lds_byte(int r, int c) { const int st = (r >> 4) * 2 + (c >> 5), rr = r & 15, cc = c & 31, ob = rr * 64 + cc * 2; return st * 1024 + (ob ^ (((ob >> 9) & 1) << 5)); }
__host__ __device__ __forceinline__ void stage_rc(int b, int& R, int& C) { const int st = b / 1024, sb = b % 1024, swz = sb ^ (((sb >> 9) & 1) << 5); R = (st >> 1) * 16 + swz / 64; C = (st & 1) * 32 + (swz % 64) / 2; }
__host__ __device__ __forceinline__ int perm32(int rho) { const int n = rho >> 4, i = rho & 15; return 8 * (i >> 2) + 4 * n + (i & 3); }
struct Unit { int pm, pn, sub; };
enum Mode { M_PROJ = 0, M_MERGE = 1, M_OUT = 2, M_SCORE = 3 };
struct Desc {
    const bf16_t* A0; const bf16_t* B0; const bf16_t* A1; const bf16_t* B1;
    int K, nM, nN, nsub, G, c, mode;
    unsigned char* ws; const float* xin; float* out;
    __device__ __forceinline__ bool next(int i, Unit& u) const {
        const int ii = (nsub == 2) ? (i >> 1) : i; u.sub = (nsub == 2) ? (i & 1) : 0;
        const int nwg = nM * nN; const long L = (long)ii * G + c; if (L >= nwg) return false;
        int wgid = (int)L; { const int q = nwg / NXCD, r = nwg % NXCD, xcd = wgid % NXCD, off = wgid / NXCD; wgid = (xcd < r ? xcd * (q + 1) : r * (q + 1) + (xcd - r) * q) + off; }
        const int nig = WGM * nN, gid = wgid / nig, fm = gid * WGM, gsz = (nM - fm) < WGM ? (nM - fm) : WGM;
        u.pm = fm + ((wgid % nig) % gsz); u.pn = (wgid % nig) / gsz; return true;
    }
};

__device__ __forceinline__ u32x4 pack8_bf16(const f32x4 a, const f32x4 b) { u32x4 w; w.x = cvt_pk_bf16(a[0], a[1]); w.y = cvt_pk_bf16(a[2], a[3]); w.z = cvt_pk_bf16(b[0], b[1]); w.w = cvt_pk_bf16(b[2], b[3]); return w; }
__device__ __forceinline__ u32x4 pack8_f16(const f32x4 a, const f32x4 b) { u32x4 w; w.x = pk_f16(a[0], a[1]); w.y = pk_f16(a[2], a[3]); w.z = pk_f16(b[0], b[1]); w.w = pk_f16(b[2], b[3]); return w; }

__device__ __forceinline__ void epi_proj(const f32x4 (&acc)[2][2][4][2], const Unit& u, int wr, int wc, int fr, int fq, unsigned char* ws) {
    const int pn = u.pn;
    const int row0 = u.pm * BM + wr * 64 + fr;
    if (pn <= 1) {
        bf16_t* O = (bf16_t*)(ws + (pn == 0 ? WS_RQ : WS_RK)); const float sc = pn == 0 ? 0.125f : 1.0f;
        const f32x2* tab = (const f32x2*)(ws + WS_TABA);
#pragma unroll
        for (int ai = 0; ai < 2; ++ai)
#pragma unroll
            for (int m = 0; m < 4; ++m) {
                const int row = row0 + ai * HALF + m * 16; const int pos = row & (SEQ - 1);
                const f32x4* tp = (const f32x4*)(tab + pos * 32 + 8 * fq);
                const f32x4 t0 = tp[0], t1 = tp[1], t2 = tp[2], t3 = tp[3];
                const float cs[8] = {t0[0], t0[2], t1[0], t1[2], t2[0], t2[2], t3[0], t3[2]}, sn[8] = {t0[1], t0[3], t1[1], t1[3], t2[1], t2[3], t3[1], t3[3]};
                f32x4 o1a, o1b, o2a, o2b;
#pragma unroll
                for (int j = 0; j < 4; ++j) {
                    const float a0 = acc[ai][0][m][0][j], b0 = acc[ai][1][m][0][j], a1 = acc[ai][0][m][1][j], b1 = acc[ai][1][m][1][j];
                    o1a[j] = (a0 * cs[j] - b0 * sn[j]) * sc; o2a[j] = (a0 * sn[j] + b0 * cs[j]) * sc;
                    o1b[j] = (a1 * cs[4 + j] - b1 * sn[4 + j]) * sc; o2b[j] = (a1 * sn[4 + j] + b1 * cs[4 + j]) * sc; }
                bf16_t* rp = O + (size_t)row * 256 + wc * 64 + 8 * fq;
                *(u32x4*)rp = pack8_bf16(o1a, o1b); *(u32x4*)(rp + 32) = pack8_bf16(o2a, o2b);
            }
        return;
    }
    if (pn >= 14) {
        unsigned char* G8 = ws + WS_GATES;
#pragma unroll
        for (int ai = 0; ai < 2; ++ai)
#pragma unroll
            for (int m = 0; m < 4; ++m) { unsigned w[4];
#pragma unroll
                for (int bj = 0; bj < 2; ++bj)
#pragma unroll
                    for (int n = 0; n < 2; ++n) { unsigned pk = 0u;
#pragma unroll
                        for (int j = 0; j < 4; ++j) pk = __builtin_amdgcn_cvt_pk_u8_f32(255.0f * sigmoidf_(acc[ai][bj][m][n][j]), j, pk);
                        w[2 * bj + n] = pk; }
                *(u32x4*)(G8 + (size_t)(row0 + ai * HALF + m * 16) * 2048 + (pn - 14) * 256 + wc * 64 + fq * 16) = (u32x4){w[0], w[1], w[2], w[3]}; }
        return;
    }
    if (pn == 2 || pn == 3 || pn == 10 || pn == 11 || pn == 4 || pn == 5) {
        bf16_t* O; int ldc, colt; int act = 0;
        if (pn <= 3) { O = (bf16_t*)(ws + WS_RV); ldc = 512; colt = (pn - 2) * 256; }
        else if (pn <= 5) { O = (bf16_t*)(ws + WS_RG); ldc = 512; colt = (pn - 4) * 256; act = 1; }
        else { O = (bf16_t*)(ws + WS_DV); ldc = 512; colt = (pn - 10) * 256; }
        const int col0 = colt + wc * 32 + 8 * fq;
#pragma unroll
        for (int ai = 0; ai < 2; ++ai)
#pragma unroll
            for (int m = 0; m < 4; ++m) { bf16_t* rowp = O + (size_t)(row0 + ai * HALF + m * 16) * ldc + col0;
#pragma unroll
                for (int bj = 0; bj < 2; ++bj) { f32x4 v0 = acc[ai][bj][m][0], v1 = acc[ai][bj][m][1];
                    if (act == 1) {
#pragma unroll
                        for (int j = 0; j < 4; ++j) { v0[j] = v0[j] * sigmoidf_(v0[j]); v1[j] = v1[j] * sigmoidf_(v1[j]); } }
                    *(u32x4*)(rowp + bj * HALF) = pack8_bf16(v0, v1); } }
        return;
    }
    if (pn == 13) {
        _Float16* OK = (_Float16*)(ws + WS_IK); float* OW = (float*)(ws + WS_IW);
        const f32x2* tab = (const f32x2*)(ws + WS_TABB);
        if (wc > 2) return;
#pragma unroll
        for (int ai = 0; ai < 2; ++ai)
#pragma unroll
            for (int m = 0; m < 4; ++m) {
                const int row = row0 + ai * HALF + m * 16; const int pos = row & (SEQ - 1);
                f32x4 v0 = acc[ai][0][m][0], v1 = acc[ai][0][m][1];
                if (wc == 2) { if (fq == 0) { *(f32x4*)(OW + (size_t)row * 4) = v0 * 0.0625f; } continue; }
                _Float16* tp_ = OK + (size_t)(row >> 5) * 2048 + (row & 31) * 8;
                if (wc == 0 && fq < 2) {
                    const f32x4* tp = (const f32x4*)(tab + pos * 8 + 4 * fq); const f32x4 t0 = tp[0], t1 = tp[1];
                    const float cs[4] = {t0[0], t0[2], t1[0], t1[2]}, sn[4] = {t0[1], t0[3], t1[1], t1[3]};
                    f32x4 o1, o2;
#pragma unroll
                    for (int j = 0; j < 4; ++j) { o1[j] = v0[j] * cs[j] - v1[j] * sn[j]; o2[j] = v0[j] * sn[j] + v1[j] * cs[j]; }
                    u32x2 w1, w2; w1.x = pk_f16(o1[0], o1[1]); w1.y = pk_f16(o1[2], o1[3]); w2.x = pk_f16(o2[0], o2[1]); w2.y = pk_f16(o2[2], o2[3]);
                    *(u32x2*)(tp_ + 4 * fq) = w1; *(u32x2*)(tp_ + 256 + 4 * fq) = w2;
                } else { const int c = 4 * wc + fq; *(u32x4*)(tp_ + (c >> 1) * 512 + (c & 1) * 256) = pack8_f16(v0, v1); }
            }
        return;
    }
    {
        const bool f16o = (pn == 12);
        bf16_t* O; int ldc, colt; float sc = 1.0f;
        if (pn <= 7) { O = (bf16_t*)(ws + WS_DQ); ldc = 512; colt = (pn - 6) * 256; sc = C2; }
        else if (pn <= 9) { O = (bf16_t*)(ws + WS_DK); ldc = 512; colt = (pn - 8) * 256; }
        else { O = (bf16_t*)(ws + WS_IQ); ldc = 256; colt = 0; }
        const f32x2* tab = (const f32x2*)(ws + WS_TABB);
        const bool rot = ((wc & 1) == 0) && (fq < 2);
#pragma unroll
        for (int ai = 0; ai < 2; ++ai)
#pragma unroll
            for (int m = 0; m < 4; ++m) {
                const int row = row0 + ai * HALF + m * 16; const int pos = row & (SEQ - 1);
                f32x4 t0 = {1.f, 0.f, 1.f, 0.f}, t1 = {1.f, 0.f, 1.f, 0.f};
                if (rot) { const f32x4* tp = (const f32x4*)(tab + pos * 8 + 4 * fq); t0 = tp[0]; t1 = tp[1]; }
                const float cs[4] = {t0[0], t0[2], t1[0], t1[2]}, sn[4] = {t0[1], t0[3], t1[1], t1[3]};
#pragma unroll
                for (int bj = 0; bj < 2; ++bj) {
                    f32x4 v0 = acc[ai][bj][m][0] * sc, v1 = acc[ai][bj][m][1] * sc;
                    bf16_t* rp = O + (size_t)row * ldc + colt + bj * HALF + wc * 32;
                    if (rot) {
                        f32x4 o1, o2;
#pragma unroll
                        for (int j = 0; j < 4; ++j) { o1[j] = v0[j] * cs[j] - v1[j] * sn[j]; o2[j] = v0[j] * sn[j] + v1[j] * cs[j]; }
                        u32x2 w1, w2;
                        if (f16o) { w1.x = pk_f16(o1[0], o1[1]); w1.y = pk_f16(o1[2], o1[3]); w2.x = pk_f16(o2[0], o2[1]); w2.y = pk_f16(o2[2], o2[3]); }
                        else { w1.x = cvt_pk_bf16(o1[0], o1[1]); w1.y = cvt_pk_bf16(o1[2], o1[3]); w2.x = cvt_pk_bf16(o2[0], o2[1]); w2.y = cvt_pk_bf16(o2[2], o2[3]); }
                        *(u32x2*)(rp + 4 * fq) = w1; *(u32x2*)(rp + 8 + 4 * fq) = w2;
                    } else { *(u32x4*)(rp + 8 * fq) = f16o ? pack8_f16(v0, v1) : pack8_bf16(v0, v1); }
                }
            }
    }
}
__device__ __forceinline__ u32x4 lane_tr(const u32x4 v, int fr, int fq) {
    const int lane = fr + 16 * fq, src = 4 * ((lane >> 2) + 16 * (lane & 3));
    u32x4 r; r.x = (unsigned)__builtin_amdgcn_ds_bpermute(src, (int)v.x); r.y = (unsigned)__builtin_amdgcn_ds_bpermute(src, (int)v.y);
    r.z = (unsigned)__builtin_amdgcn_ds_bpermute(src, (int)v.z); r.w = (unsigned)__builtin_amdgcn_ds_bpermute(src, (int)v.w); return r;
}
__device__ __forceinline__ void epi_merge(f32x4 (&acc)[2][2][4][2], const Unit& u, int wr, int wc, int fr, int fq, unsigned char* ws) {
    const unsigned char* G8 = ws + WS_GATES; bf16_t* O = (bf16_t*)(ws + WS_MERGED);
    const int row0 = u.pm * BM + wr * 64 + fr, col0 = u.pn * BM + wc * 32 + 8 * fq;
    const int rowS = u.pm * BM + wr * 64 + ((fr + 16 * fq) >> 2), colS = u.pn * BM + wc * 32 + 8 * ((fr + 16 * fq) & 3);
    const int goff = wc * 64 + fq * 16;
    constexpr float K = 1.0f / 255.0f;
#pragma unroll
    for (int ai = 0; ai < 2; ++ai)
#pragma unroll
        for (int m = 0; m < 4; ++m) { const size_t row = (size_t)(row0 + ai * HALF + m * 16);
            const u32x4 gd = *(const u32x4*)(G8 + row * 2048 + (4 + u.pn) * 256 + goff);
            const unsigned gdw[4] = {gd.x, gd.y, gd.z, gd.w};
            if (u.sub == 0) {
                const u32x4 gr = *(const u32x4*)(G8 + row * 2048 + u.pn * 256 + goff);
                const unsigned grw[4] = {gr.x, gr.y, gr.z, gr.w};
#pragma unroll
                for (int bj = 0; bj < 2; ++bj)
#pragma unroll
                    for (int n = 0; n < 2; ++n)
#pragma unroll
                        for (int j = 0; j < 4; ++j) { const float d = (float)((gdw[2 * bj + n] >> (8 * j)) & 0xffu) * K, r = (float)((grw[2 * bj + n] >> (8 * j)) & 0xffu) * K;
                            acc[ai][bj][m][n][j] *= r * __builtin_amdgcn_rcpf(fmaxf(d, 1e-20f)); }
            } else {
#pragma unroll
                for (int bj = 0; bj < 2; ++bj) { f32x4 v0, v1;
#pragma unroll
                    for (int j = 0; j < 4; ++j) { v0[j] = acc[ai][bj][m][0][j] * fmaxf((float)((gdw[2 * bj] >> (8 * j)) & 0xffu) * K, 1e-20f); v1[j] = acc[ai][bj][m][1][j] * fmaxf((float)((gdw[2 * bj + 1] >> (8 * j)) & 0xffu) * K, 1e-20f); }
                    *(u32x4*)(O + (size_t)(rowS + ai * HALF + m * 16) * 1024 + colS + bj * HALF) = lane_tr(pack8_bf16(v0, v1), fr, fq); }
            } }
}
__device__ __forceinline__ void epi_out(const f32x4 (&acc)[2][2][4][2], const Unit& u, int wr, int wc, int fr, int fq, unsigned char* ws, const float* xin, float* out) {
    bf16_t* XB = (bf16_t*)(ws + WS_X1B); const bf16_t* XR = (const bf16_t*)(ws + WS_XB); (void)out; (void)xin;
    const int row0 = u.pm * BM + wr * 64 + fr, col0 = u.pn * BM + wc * 32 + 8 * fq;
    const int rowS = u.pm * BM + wr * 64 + ((fr + 16 * fq) >> 2), colS = u.pn * BM + wc * 32 + 8 * ((fr + 16 * fq) & 3);
#pragma unroll
    for (int ai = 0; ai < 2; ++ai)
#pragma unroll
        for (int m = 0; m < 4; ++m) { const size_t off = (size_t)(row0 + ai * HALF + m * 16) * 1024 + col0, offS = (size_t)(rowS + ai * HALF + m * 16) * 1024 + colS;
#pragma unroll
            for (int bj = 0; bj < 2; ++bj) { const u32x4 xr = *(const u32x4*)(XR + off + bj * HALF);
                const f32x4 x0 = {bf2f(xr.x & 0xffffu), bf2f(xr.x >> 16), bf2f(xr.y & 0xffffu), bf2f(xr.y >> 16)}, x1 = {bf2f(xr.z & 0xffffu), bf2f(xr.z >> 16), bf2f(xr.w & 0xffffu), bf2f(xr.w >> 16)};
                *(u32x4*)(XB + offS + bj * HALF) = lane_tr(pack8_bf16(x0 + acc[ai][bj][m][0], x1 + acc[ai][bj][m][1]), fr, fq); } }
}
__device__ __forceinline__ void epi_score(const f32x4 (&acc)[2][2][4][2], const Unit& u, int wr, int wc, int fr, int fq, unsigned char* ws) {
    _Float16* O = (_Float16*)(ws + WS_SC);
    const int rowS = u.pm * BM + wr * 64 + ((fr + 16 * fq) >> 2), colS = u.pn * BM + wc * 32 + 8 * ((fr + 16 * fq) & 3);
#pragma unroll
    for (int ai = 0; ai < 2; ++ai)
#pragma unroll
        for (int m = 0; m < 4; ++m) { _Float16* rowp = O + (size_t)(rowS + ai * HALF + m * 16) * 2048 + colS;
#pragma unroll
            for (int bj = 0; bj < 2; ++bj) *(u32x4*)(rowp + bj * HALF) = lane_tr(pack8_f16(acc[ai][bj][m][0], acc[ai][bj][m][1]), fr, fq); }
}

__device__ __forceinline__ void gemm_phase(LAS unsigned char* lds, const Desc& S) {
    const int tid = threadIdx.x, wid = __builtin_amdgcn_readfirstlane(tid >> 6), lane = tid & 63, wr = wid >> 2, wc = wid & 3, fr = lane & 15, fq = lane >> 4;
    const int K = S.K, nt = K / BK;
    const bool PERM = true;
    unsigned voffA[2], voffB[2];
#pragma unroll
    for (int i = 0; i < 2; ++i) { int R, C; stage_rc(tid * 16 + i * 8192, R, C); const int Rb = PERM ? ((R & ~31) + perm32(R & 31)) : R;
        voffA[i] = (unsigned)(R * K + C) * 2u; voffB[i] = (unsigned)(Rb * K + C) * 2u; }
    const size_t kstep = (size_t)(BK * 2);
    const size_t hstep = (size_t)HALF * K * 2;
    const size_t tstep = 2 * hstep;
    const unsigned ldsw = (unsigned)wid * 1024u;
    const int aoff = lds_byte(wr * 64 + fr, fq * 8), boff = lds_byte(wc * 32 + fr, fq * 8);
#define PG8_SA(b, h) (((b) * 2 + (h)) * HTB)
#define PG8_SB(b, h) ((4 + (b) * 2 + (h)) * HTB)
#define PG8_STAGE(bufoff, gbase, voff) do { _Pragma("unroll") for (int _i = 0; _i < 2; ++_i) \
        __builtin_amdgcn_global_load_lds((const unsigned*)((const char*)(gbase) + (voff)[_i]), (LAS unsigned*)(lds + (bufoff) + ldsw + _i * 8192), 16, 0, 0); } while (0)
#define PG8_LDA(dst, b, h) do { _Pragma("unroll") for (int m = 0; m < 4; ++m) _Pragma("unroll") for (int k = 0; k < 2; ++k) dst[m][k] = *(const LAS bf16x8*)(lds + PG8_SA(b, h) + aoff + m * 2048 + k * 1024); } while (0)
#define PG8_LDB(dst, b, h) do { _Pragma("unroll") for (int n = 0; n < 2; ++n) _Pragma("unroll") for (int k = 0; k < 2; ++k) dst[n][k] = *(const LAS bf16x8*)(lds + PG8_SB(b, h) + boff + n * 2048 + k * 1024); } while (0)
#define PG8_MMA(ai, bj, At, Bt) do { __builtin_amdgcn_s_setprio(1); _Pragma("unroll") for (int m = 0; m < 4; ++m) _Pragma("unroll") for (int n = 0; n < 2; ++n) _Pragma("unroll") for (int k = 0; k < 2; ++k) \
        acc[ai][bj][m][n] = __builtin_amdgcn_mfma_f32_16x16x32_bf16(Bt[n][k], At[m][k], acc[ai][bj][m][n], 0, 0, 0); __builtin_amdgcn_s_setprio(0); } while (0)
#define PG8_WAIT_V(n) asm volatile("s_waitcnt vmcnt(" #n ")" ::: "memory")
#define PG8_WAIT_L(n) asm volatile("s_waitcnt lgkmcnt(" #n ")" ::: "memory")
#define PG8_BAR __builtin_amdgcn_s_barrier()
#define PG8_SCHED __builtin_amdgcn_sched_barrier(0)
#define PG8_UA(u) ((const char*)((u).sub ? S.A1 : S.A0) + (size_t)(u).pm * tstep)
#define PG8_UB(u) ((const char*)((u).sub ? S.B1 : S.B0) + (size_t)(u).pn * tstep)
    Unit cur, nxt; int ui = 0;
    if (!S.next(0, cur)) return;
    f32x4 acc[2][2][4][2];
#pragma unroll
    for (int a = 0; a < 2; ++a)
#pragma unroll
        for (int b = 0; b < 2; ++b)
#pragma unroll
            for (int m = 0; m < 4; ++m)
#pragma unroll
                for (int n = 0; n < 2; ++n) acc[a][b][m][n] = (f32x4){0.f, 0.f, 0.f, 0.f};
    bf16x8 At[4][2], B0[2][2], B1[2][2];
    const char* cA = PG8_UA(cur); const char* cB = PG8_UB(cur);
    PG8_STAGE(PG8_SB(0, 0), cB, voffB); PG8_STAGE(PG8_SB(0, 1), cB + hstep, voffB); PG8_STAGE(PG8_SA(0, 0), cA, voffA); PG8_STAGE(PG8_SA(0, 1), cA + hstep, voffA);
    if (wr == 1) PG8_BAR;
    PG8_WAIT_V(2); PG8_BAR;
    PG8_STAGE(PG8_SB(1, 0), cB + kstep, voffB); PG8_STAGE(PG8_SA(1, 0), cA + kstep, voffA); PG8_STAGE(PG8_SB(1, 1), cB + hstep + kstep, voffB);
    PG8_WAIT_V(6); PG8_BAR;
    for (;;) {
        const bool has_next = S.next(ui + 1, nxt);
        const char* nA = has_next ? PG8_UA(nxt) : cA; const char* nB = has_next ? PG8_UB(nxt) : cB;
        for (int t = 0; t < nt; t += 2) {
            const bool last = (t == nt - 2);
            const char* a1 = cA + (size_t)(t + 1) * kstep;
            const char* a2 = last ? nA : cA + (size_t)(t + 2) * kstep; const char* b2 = last ? nB : cB + (size_t)(t + 2) * kstep;
            const char* a3 = a2 + kstep; const char* b3 = b2 + kstep;
            PG8_LDB(B0, 0, 0); PG8_LDB(B1, 0, 1); PG8_SCHED; PG8_LDA(At, 0, 0); PG8_STAGE(PG8_SA(1, 1), a1 + hstep, voffA);
            PG8_WAIT_V(8); PG8_WAIT_L(0); PG8_BAR; PG8_MMA(0, 0, At, B0); PG8_MMA(0, 1, At, B1); PG8_BAR; PG8_SCHED;
            PG8_LDA(At, 0, 1); PG8_STAGE(PG8_SB(0, 0), b2, voffB); PG8_STAGE(PG8_SB(0, 1), b2 + hstep, voffB); PG8_STAGE(PG8_SA(0, 0), a2, voffA);
            PG8_WAIT_V(8); PG8_WAIT_L(0); PG8_BAR; PG8_MMA(1, 0, At, B0); PG8_MMA(1, 1, At, B1); PG8_BAR; PG8_SCHED;
            PG8_LDB(B0, 1, 0); PG8_LDB(B1, 1, 1); PG8_SCHED; PG8_LDA(At, 1, 0); PG8_STAGE(PG8_SA(0, 1), a2 + hstep, voffA);
            PG8_WAIT_V(8); PG8_WAIT_L(0); PG8_BAR; PG8_MMA(0, 0, At, B0); PG8_MMA(0, 1, At, B1); PG8_BAR; PG8_SCHED;
            PG8_LDA(At, 1, 1); PG8_STAGE(PG8_SB(1, 0), b3, voffB); PG8_STAGE(PG8_SB(1, 1), b3 + hstep, voffB); PG8_STAGE(PG8_SA(1, 0), a3, voffA);
            PG8_WAIT_V(8); PG8_WAIT_L(0); PG8_BAR; PG8_MMA(1, 0, At, B0); PG8_MMA(1, 1, At, B1); PG8_BAR; PG8_SCHED;
        }
        if (wr == 0) PG8_BAR;
        bool keep = false;
        if (S.mode == M_PROJ) {
            const float* RS = (const float*)(S.ws + WS_RSTD) + cur.pm * BM + wr * 64 + fr;
#pragma unroll
            for (int a = 0; a < 2; ++a)
#pragma unroll
                for (int m = 0; m < 4; ++m) { const float r = RS[a * HALF + m * 16];
#pragma unroll
                    for (int b = 0; b < 2; ++b)
#pragma unroll
                        for (int n = 0; n < 2; ++n) acc[a][b][m][n] *= r; }
            epi_proj(acc, cur, wr, wc, fr, fq, S.ws); }
        else if (S.mode == M_MERGE) { epi_merge(acc, cur, wr, wc, fr, fq, S.ws); keep = (cur.sub == 0); }
        else if (S.mode == M_OUT) epi_out(acc, cur, wr, wc, fr, fq, S.ws, S.xin, S.out);
        else epi_score(acc, cur, wr, wc, fr, fq, S.ws);
        if (!has_next) break;
        if (!keep) {
#pragma unroll
            for (int a = 0; a < 2; ++a)
#pragma unroll
                for (int b = 0; b < 2; ++b)
#pragma unroll
                    for (int m = 0; m < 4; ++m)
#pragma unroll
                        for (int n = 0; n < 2; ++n) acc[a][b][m][n] = (f32x4){0.f, 0.f, 0.f, 0.f};
        }
        cur = nxt; cA = nA; cB = nB; ++ui;
        if (wr == 1) PG8_BAR;
    }
    PG8_WAIT_V(0);
    PG8_BAR;
#undef PG8_SA
#undef PG8_SB
#undef PG8_STAGE
#undef PG8_LDA
#undef PG8_LDB
#undef PG8_MMA
#undef PG8_WAIT_V
#undef PG8_WAIT_L
#undef PG8_BAR
#undef PG8_SCHED
#undef PG8_UA
#undef PG8_UB
}
}

namespace attn_body {
using bf16 = __hip_bfloat16;
constexpr int NHEAD = 8, D = 64, DM = NHEAD * D;
constexpr int NW = 8, QBLK = 32, QB = QBLK * NW, KVBLK = 64, NQB = SEQ / QB;
__device__ __forceinline__ int crow(int r, int hi) { return (r & 3) + 8 * (r >> 2) + 4 * hi; }
#define SBAR() __builtin_amdgcn_sched_barrier(0)
constexpr int NSLOT = 3, SLOTB = 8192;
constexpr int LDS_K = 0, LDS_V = NSLOT * SLOTB, LDS_WS = 2 * NSLOT * SLOTB, LDS_OST = LDS_WS + NW * 64 * 4, LDS_M = LDS_OST + NW * 4096, LDS_TBL = LDS_M + NW * 2048, LDS_BYTES = LDS_TBL + 256;
__device__ __forceinline__ void glds16(const void* gsrc, unsigned lds_dst) { unsigned keep;
    asm volatile("s_mov_b32 %0, m0\n\ts_mov_b32 m0, %2\n\ts_nop 0\n\tglobal_load_lds_dwordx4 %1, off\n\ts_mov_b32 m0, %0" : "=&s"(keep) : "v"(gsrc), "s"(lds_dst) : "memory"); }
__device__ __forceinline__ float max3f(float a, float b, float c) { float r; asm("v_max3_f32 %0, %1, %2, %3" : "=v"(r) : "v"(a), "v"(b), "v"(c)); return r; }
__device__ __forceinline__ float max2f(float a, float b) { float r; asm("v_max_f32_e32 %0, %1, %2" : "=v"(r) : "v"(a), "v"(b)); return r; }
__device__ __forceinline__ float fadd_s(float a, float b) { float r; asm("v_add_f32_e32 %0, %1, %2" : "=v"(r) : "v"(a), "v"(b)); return r; }
__device__ __forceinline__ float fsub_s(float a, float b) { float r; asm("v_sub_f32_e32 %0, %1, %2" : "=v"(r) : "v"(a), "v"(b)); return r; }
typedef __bf16 bf16x2_t __attribute__((ext_vector_type(2)));
__device__ __forceinline__ unsigned cvtpk_s(float lo, float hi) { f32x2 v = {lo, hi}; bf16x2_t b = __builtin_convertvector(v, bf16x2_t); return __builtin_bit_cast(unsigned, b); }
#define WAIT_BAR(N) asm volatile("s_waitcnt vmcnt(" #N ") lgkmcnt(0)\n\ts_barrier" ::: "memory")
__device__ __forceinline__ void qkt(f32x16& p0, f32x16& p1, const char* Kslot, const bf16x8* qr, int r32, int hi) {
    const char* kb = Kslot + hi * 1024 + r32 * 16;
#pragma unroll
    for (int d0 = 0; d0 < 4; ++d0) {
        const bf16x8 b0 = *reinterpret_cast<const bf16x8*>(kb + d0 * 2048);
        const bf16x8 b1 = *reinterpret_cast<const bf16x8*>(kb + d0 * 2048 + 512);
        p0 = __builtin_amdgcn_mfma_f32_32x32x16_bf16(b0, qr[d0], p0, 0, 0, 0); p1 = __builtin_amdgcn_mfma_f32_32x32x16_bf16(b1, qr[d0], p1, 0, 0, 0); }
}
typedef LAS const char* lds_cptr;
typedef short v4i16_t __attribute__((ext_vector_type(4)));
__device__ __forceinline__ void kload8(bf16x8* kf, lds_cptr kp) {
    kf[0] = *(const LAS bf16x8*)(kp);        kf[1] = *(const LAS bf16x8*)(kp + 512);
    kf[2] = *(const LAS bf16x8*)(kp + 2048); kf[3] = *(const LAS bf16x8*)(kp + 2560);
    kf[4] = *(const LAS bf16x8*)(kp + 4096); kf[5] = *(const LAS bf16x8*)(kp + 4608);
    kf[6] = *(const LAS bf16x8*)(kp + 6144); kf[7] = *(const LAS bf16x8*)(kp + 6656);
}
__device__ __forceinline__ void kload2(bf16x8* kf, lds_cptr kp, int j) { kf[2 * j] = *(const LAS bf16x8*)(kp + j * 2048); kf[2 * j + 1] = *(const LAS bf16x8*)(kp + j * 2048 + 512); }
__device__ __forceinline__ s16x4 vtr(lds_cptr p) { return __builtin_bit_cast(s16x4, __builtin_amdgcn_ds_read_tr16_b64_v4i16((LAS v4i16_t*)p)); }
__device__ __forceinline__ float rowmax(const f32x16& p0, const f32x16& p1) {
    float a = max3f(p0[0], p0[1], p1[0]), b = max3f(p0[2], p0[3], p1[1]); a = max3f(a, p1[2], p1[3]);
#pragma unroll
    for (int r = 4; r < 16; r += 4) { a = max3f(a, p0[r], p0[r + 1]); b = max3f(b, p0[r + 2], p0[r + 3]); a = max3f(a, p1[r], p1[r + 1]); b = max3f(b, p1[r + 2], p1[r + 3]); }
    const float m = max2f(a, b);
    auto rr = __builtin_amdgcn_permlane32_swap(__float_as_uint(m), __float_as_uint(m), false, false);
    return max2f(__uint_as_float(rr[0]), __uint_as_float(rr[1]));
}
__device__ __forceinline__ void pv(f32x16* o, int vb, bf16x8 pa0, bf16x8 pa1, bf16x8 pa2, bf16x8 pa3) {
#pragma unroll
    for (int d0 = 0; d0 < 2; ++d0) { s16x4 lo[4], hi[4];
#pragma unroll
        for (int ks = 0; ks < 4; ++ks) {
            asm volatile("ds_read_b64_tr_b16 %0,%1 offset:%c2" : "=&v"(lo[ks]) : "v"(vb), "i"(d0 * 4096 + ks * 1024) : "memory");
            asm volatile("ds_read_b64_tr_b16 %0,%1 offset:%c2" : "=&v"(hi[ks]) : "v"(vb), "i"(d0 * 4096 + ks * 1024 + 512) : "memory"); }
        asm volatile("s_waitcnt lgkmcnt(0)" ::: "memory"); SBAR();
#define PK(k) (bf16x8){lo[k][0], lo[k][1], lo[k][2], lo[k][3], hi[k][0], hi[k][1], hi[k][2], hi[k][3]}
        o[d0] = __builtin_amdgcn_mfma_f32_32x32x16_bf16(pa0, PK(0), o[d0], 0, 0, 0);
        o[d0] = __builtin_amdgcn_mfma_f32_32x32x16_bf16(pa1, PK(1), o[d0], 0, 0, 0);
        o[d0] = __builtin_amdgcn_mfma_f32_32x32x16_bf16(pa2, PK(2), o[d0], 0, 0, 0);
        o[d0] = __builtin_amdgcn_mfma_f32_32x32x16_bf16(pa3, PK(3), o[d0], 0, 0, 0);
#undef PK
    }
}
__device__ __forceinline__ void mask_init(f32x16& p0, f32x16& p1, lds_cptr mp, lds_cptr tbl, int hi, float nm) {
    const u32x2 mw = *(const LAS u32x2*)mp;
    const unsigned lo = mw.x >> (4 * hi), hh = mw.y >> (4 * hi);
#pragma unroll
    for (int g = 0; g < 4; ++g) {
        const f32x4 b0 = *(const LAS f32x4*)(tbl + ((lo >> (8 * g)) & 15u) * 16);
        const f32x4 b1 = *(const LAS f32x4*)(tbl + ((hh >> (8 * g)) & 15u) * 16);
#pragma unroll
        for (int j = 0; j < 4; ++j) { p0[4 * g + j] = b0[j] + nm; p1[4 * g + j] = b1[j] + nm; }
    }
}
__device__ __forceinline__ void mask_load(f32x16& p0, f32x16& p1, u32x2 mw, lds_cptr tbl, int hi) {
    const unsigned lo = mw.x >> (4 * hi), hh = mw.y >> (4 * hi);
#pragma unroll
    for (int g = 0; g < 4; ++g) {
        const f32x4 b0 = *(const LAS f32x4*)(tbl + ((lo >> (8 * g)) & 15u) * 16);
        const f32x4 b1 = *(const LAS f32x4*)(tbl + ((hh >> (8 * g)) & 15u) * 16);
#pragma unroll
        for (int j = 0; j < 4; ++j) { p0[4 * g + j] = b0[j]; p1[4 * g + j] = b1[j]; }
    }
}
__device__ __forceinline__ void mask_add(f32x16& p0, f32x16& p1, float nm) {
#pragma unroll
    for (int r = 0; r < 16; ++r) { p0[r] += nm; p1[r] += nm; }
}
template <int THRL> __device__ __forceinline__ void attn_unit(int b, int h, int qb, const bf16* Q, const bf16* __restrict__ K, const bf16* __restrict__ V, bf16* O, const unsigned long long* BMp, char* shm) {
    const int tid = threadIdx.x, lane = tid & 63, r32 = lane & 31, hi = lane >> 5; const int wid = __builtin_amdgcn_readfirstlane(tid >> 6);
    const long rowbase = (long)b * SEQ; const int q0 = qb * QB;
    const bf16* Qw = Q + (rowbase + q0 + wid * QBLK) * DM + h * D;
    const bf16* Kh = K + rowbase * DM + h * D, *Vh = V + rowbase * DM + h * D;
    const unsigned lds0 = (unsigned)(uintptr_t)shm;
    float* wsf = (float*)(shm + LDS_WS) + wid * 64;
    const bf16* ksrc = Kh + (long)lane * DM + wid * 8;
    const bf16* vsrc = Vh + (long)(16 * (wid & 3) + (lane >> 2)) * DM + (wid >> 2) * 32 + (lane & 3) * 8;
    const unsigned kdst = lds0 + LDS_K + wid * 1024, vdst = lds0 + LDS_V + wid * 1024;
    const unsigned long long* msrc = BMp + ((size_t)(b * 128 + (lane >> 4)) * SEQ + q0 + wid * QBLK + 2 * (lane & 15));
    const unsigned mdst = lds0 + LDS_M + wid * 2048;
#define DMA_K(t, slot) glds16(ksrc + (long)(t) * KVBLK * DM, (unsigned)__builtin_amdgcn_readfirstlane(kdst + (slot)))
#define DMA_V(t, slot) glds16(vsrc + (long)(t) * KVBLK * DM, (unsigned)__builtin_amdgcn_readfirstlane(vdst + (slot)))
#define DMA_M(g) glds16(msrc + (size_t)(g) * 4 * SEQ, (unsigned)__builtin_amdgcn_readfirstlane(mdst + ((g) & 1) * 1024))
    const int vb0 = (int)(lds0 + LDS_V) + ((lane >> 4) & 1) * 32 + (lane & 3) * 8 + (4 * hi + ((lane & 15) >> 2)) * 64;
    const char* Kbase = shm + LDS_K; bf16x8 kf[8];
    const lds_cptr shm3 = (lds_cptr)shm; const lds_cptr kp0 = shm3 + LDS_K + hi * 1024 + r32 * 16; const lds_cptr vp0 = shm3 + LDS_V + ((lane >> 4) & 1) * 32 + (lane & 3) * 8 + (4 * hi + ((lane & 15) >> 2)) * 64;
    const lds_cptr mp0 = shm3 + LDS_M + wid * 2048 + r32 * 8; const lds_cptr tblp = shm3 + LDS_TBL;
    const int NT = (q0 + QB) / KVBLK;
    DMA_M(0); DMA_K(0, 0); DMA_V(0, 0); DMA_K(1, SLOTB);
    bf16x8 qr[4];
#pragma unroll
    for (int d0 = 0; d0 < 4; ++d0) qr[d0] = *reinterpret_cast<const bf16x8*>(&Qw[(long)r32 * DM + d0 * 16 + hi * 8]);
    float mhat = 0.f, l_reg = 0.f; f32x16 o[2]; o[0] = f32x16{}; o[1] = f32x16{};
#define MINIT(P0, P1, t) mask_init(P0, P1, mp0 + ((((t) >> 2) & 1) * 1024 + ((t) & 3) * 256), tblp, hi, -mhat)
#define MWORD(t) (*(const LAS u32x2*)(mp0 + ((((t) >> 2) & 1) * 1024 + ((t) & 3) * 256)))
    bool resc = false;
#define START(P0, P1) do { const float rm = rowmax(P0, P1); resc = false; \
    { const float dl = __builtin_fmaxf(rm, -64.f); mhat = fadd_s(mhat, dl); \
      _Pragma("unroll") for (int r = 0; r < 16; ++r) { P0[r] = fsub_s(P0[r], dl); P1[r] = fsub_s(P1[r], dl); } \
    } \
    _Pragma("unroll") for (int r = 0; r < 16; ++r) P0[r] = __builtin_amdgcn_exp2f(P0[r]); } while (0)
#define RESC() do { if (resc) { asm volatile("s_waitcnt lgkmcnt(0)" ::: "memory"); \
      _Pragma("unroll") for (int d_ = 0; d_ < 2; ++d_) _Pragma("unroll") for (int r = 0; r < 16; ++r) o[d_][r] *= wsf[crow(r, hi)]; } } while (0)
    f32x16 pA0, pA1, pB0, pB1;
    int sl_prev = 0, sl_cur = 0, sl_next = SLOTB;
#define ROT() do { sl_prev = sl_cur; sl_cur = sl_next; sl_next = (sl_next == (NSLOT - 1) * SLOTB) ? 0 : sl_next + SLOTB; } while (0)
    DMA_K(2, 2 * SLOTB);
    WAIT_BAR(3);
    MINIT(pA0, pA1, 0);
    qkt(pA0, pA1, Kbase, qr, r32, hi); asm volatile("s_nop 15\n\ts_nop 7" : "+v"(pA0), "+v"(pA1));
    START(pA0, pA1);
    _Pragma("unroll") for (int r = 0; r < 16; ++r) pA1[r] = __builtin_amdgcn_exp2f(pA1[r]);
    WAIT_BAR(0);
    DMA_K(3, 0); DMA_V(1, SLOTB);
    ROT();
    kload8(kf, kp0 + sl_cur);
    mask_load(pB0, pB1, MWORD(1), tblp, hi);
    WAIT_BAR(2);
    s16x4 vlo[8], vhi[8]; u32x4 pw0, pw1, pw2, pw3;
#define PKW(P, B) cvtpk_s(P[B], P[B + 1])
#define PAF(k) __builtin_bit_cast(bf16x8, pw##k)
#define VFR(i) (bf16x8){vlo[i][0], vlo[i][1], vlo[i][2], vlo[i][3], vhi[i][0], vhi[i][1], vhi[i][2], vhi[i][3]}
#define PIN(x) asm volatile("" : "+v"(x))
#define MX3(a, b, c) __builtin_fmaxf(__builtin_fmaxf((a), (b)), (c))
#define GAPA(MF, A0, A1, A2, A3, W0, W1, PW) do { MF; sacc += A0; sacc += A1; sacc += A2; sacc += A3; PIN(sacc); W0; W1; PIN(PW); SBAR(); } while (0)
#define EX(v) __builtin_amdgcn_exp2f(v)
#define GAPB(MF, X, B) do { MF; X[B] = EX(X[B]); X[B + 1] = EX(X[B + 1]); X[B + 2] = EX(X[B + 2]); X[B + 3] = EX(X[B + 3]); PIN(X); SBAR(); } while (0)
#define VRD(i) do { vlo[i] = vtr(vp_ + (((i) >> 2) * 4096 + ((i) & 3) * 1024)); vhi[i] = vtr(vp_ + (((i) >> 2) * 4096 + ((i) & 3) * 1024 + 512)); } while (0)
#define KRD(G, j) do { if (G) { kload2(kf, kp0 + sl_next, j); SBAR(); } } while (0)
#define STEP(C0, C1, P0, P1, t, GK, GV, GL) do { SBAR(); \
    u32x2 mwn_ = {0u, 0u}; if ((t) + 1 < NT) mwn_ = MWORD((t) + 1); \
    mask_add(C0, C1, -mhat); SBAR(); \
    const lds_cptr vp_ = vp0 + sl_prev; \
    VRD(0); SBAR(); float sacc = (P0[0] + P0[1]); \
    GAPA(C0 = __builtin_amdgcn_mfma_f32_32x32x16_bf16(kf[0], qr[0], C0, 0, 0, 0), P0[2], P0[3], P0[4], P0[5],     pw0[0] = PKW(P0, 0), pw0[1] = PKW(P0, 2), pw0); \
    VRD(4); SBAR(); GAPA(C1 = __builtin_amdgcn_mfma_f32_32x32x16_bf16(kf[1], qr[0], C1, 0, 0, 0), P0[6], P0[7], P0[8], P0[9],     pw0[2] = PKW(P0, 4), pw0[3] = PKW(P0, 6), pw0); \
    VRD(1); SBAR(); GAPA(C0 = __builtin_amdgcn_mfma_f32_32x32x16_bf16(kf[2], qr[1], C0, 0, 0, 0),   P0[10], P0[11], P0[12], P0[13], pw1[0] = PKW(P0, 8), pw1[1] = PKW(P0, 10), pw1); \
    VRD(5); SBAR(); GAPA(C1 = __builtin_amdgcn_mfma_f32_32x32x16_bf16(kf[3], qr[1], C1, 0, 0, 0),   P0[14], P0[15], P1[0], P1[1],   pw1[2] = PKW(P0, 12), pw1[3] = PKW(P0, 14), pw1); \
    VRD(2); SBAR(); GAPA(C0 = __builtin_amdgcn_mfma_f32_32x32x16_bf16(kf[4], qr[2], C0, 0, 0, 0),   P1[2], P1[3], P1[4], P1[5],     pw2[0] = PKW(P1, 0), pw2[1] = PKW(P1, 2), pw2); \
    VRD(6); SBAR(); GAPA(C1 = __builtin_amdgcn_mfma_f32_32x32x16_bf16(kf[5], qr[2], C1, 0, 0, 0),   P1[6], P1[7], P1[8], P1[9],     pw2[2] = PKW(P1, 4), pw2[3] = PKW(P1, 6), pw2); \
    VRD(3); SBAR(); GAPA(C0 = __builtin_amdgcn_mfma_f32_32x32x16_bf16(kf[6], qr[3], C0, 0, 0, 0),   P1[10], P1[11], P1[12], P1[13], pw3[0] = PKW(P1, 8), pw3[1] = PKW(P1, 10), pw3); \
    VRD(7); SBAR(); GAPA(C1 = __builtin_amdgcn_mfma_f32_32x32x16_bf16(kf[7], qr[3], C1, 0, 0, 0),   P1[14], P1[15], 0.f, 0.f,       pw3[2] = PKW(P1, 12), pw3[3] = PKW(P1, 14), pw3); \
    l_reg += sacc; \
    if ((((t) & 3) == 1) && ((t) + 3 < NT)) { DMA_M(((t) >> 2) + 1); } \
    if (GK) { DMA_K((t) + 3, sl_cur); } if (GV) { DMA_V((t) + 1, sl_next); } \
    { float a = MX3(C0[0], C0[1], C1[0]), b = MX3(C0[2], C0[3], C1[1]); a = MX3(a, C1[2], C1[3]); \
      _Pragma("unroll") for (int r = 4; r < 16; r += 4) { a = MX3(a, C0[r], C0[r + 1]); b = MX3(b, C0[r + 2], C0[r + 3]); a = MX3(a, C1[r], C1[r + 1]); b = MX3(b, C1[r + 2], C1[r + 3]); } \
      float rm = __builtin_fmaxf(a, b); { auto rr = __builtin_amdgcn_permlane32_swap(__float_as_uint(rm), __float_as_uint(rm), false, false); rm = __builtin_fmaxf(__uint_as_float(rr[0]), __uint_as_float(rr[1])); } \
      resc = false; \
      if (__builtin_expect(__any(rm > (float)THRL), 0)) { const float dl = __builtin_fmaxf(rm, 0.f); mhat += dl; \
        _Pragma("unroll") for (int r = 0; r < 16; ++r) { C0[r] -= dl; C1[r] -= dl; } \
        const float f = __builtin_amdgcn_exp2f(-dl); l_reg *= f; if (hi == 0) wsf[r32] = f; resc = true; } } \
    if ((t) + 1 < NT) mask_load(P0, P1, mwn_, tblp, hi); \
    SBAR(); \
    GAPB(o[0] = __builtin_amdgcn_mfma_f32_32x32x16_bf16(PAF(0), VFR(0), o[0], 0, 0, 0), C0, 0); \
    GAPB(o[1] = __builtin_amdgcn_mfma_f32_32x32x16_bf16(PAF(0), VFR(4), o[1], 0, 0, 0), C0, 4); \
    KRD(GL, 0); GAPB(o[0] = __builtin_amdgcn_mfma_f32_32x32x16_bf16(PAF(1), VFR(1), o[0], 0, 0, 0), C0, 8); \
    KRD(GL, 1); GAPB(o[1] = __builtin_amdgcn_mfma_f32_32x32x16_bf16(PAF(1), VFR(5), o[1], 0, 0, 0), C0, 12); \
    KRD(GL, 2); GAPB(o[0] = __builtin_amdgcn_mfma_f32_32x32x16_bf16(PAF(2), VFR(2), o[0], 0, 0, 0), C1, 0); \
    KRD(GL, 3); GAPB(o[1] = __builtin_amdgcn_mfma_f32_32x32x16_bf16(PAF(2), VFR(6), o[1], 0, 0, 0), C1, 4); \
    GAPB(o[0] = __builtin_amdgcn_mfma_f32_32x32x16_bf16(PAF(3), VFR(3), o[0], 0, 0, 0), C1, 8); \
    GAPB(o[1] = __builtin_amdgcn_mfma_f32_32x32x16_bf16(PAF(3), VFR(7), o[1], 0, 0, 0), C1, 12); \
    } while (0)
    int t = 1;
    for (; t + 5 < NT; t += 2) {
        STEP(pB0, pB1, pA0, pA1, t, true, true, true);     WAIT_BAR(2); RESC(); ROT();
        STEP(pA0, pA1, pB0, pB1, t + 1, true, true, true);   WAIT_BAR(2); RESC(); ROT();
    }
#define ENDW(tt) do { if ((tt) + 3 < NT) { WAIT_BAR(2); } else if ((tt) + 2 < NT) { WAIT_BAR(1); } else { WAIT_BAR(0); } } while (0)
    for (; t + 1 < NT; t += 2) {
        STEP(pB0, pB1, pA0, pA1, t, (t + 3 < NT), (t + 1 < NT), (t + 1 < NT));       ENDW(t);   RESC(); ROT();
        STEP(pA0, pA1, pB0, pB1, t + 1, (t + 4 < NT), (t + 2 < NT), (t + 2 < NT));     ENDW(t + 1); RESC(); ROT();
    }
    STEP(pB0, pB1, pA0, pA1, NT - 1, false, false, false); RESC();
    { float sacc = pB0[0] + pB0[1]; _Pragma("unroll") for (int r = 2; r < 16; ++r) sacc += pB0[r]; _Pragma("unroll") for (int r = 0; r < 16; ++r) sacc += pB1[r]; l_reg += sacc;
      pw0 = (u32x4){PKW(pB0, 0), PKW(pB0, 2), PKW(pB0, 4), PKW(pB0, 6)}; pw1 = (u32x4){PKW(pB0, 8), PKW(pB0, 10), PKW(pB0, 12), PKW(pB0, 14)}; pw2 = (u32x4){PKW(pB1, 0), PKW(pB1, 2), PKW(pB1, 4), PKW(pB1, 6)}; pw3 = (u32x4){PKW(pB1, 8), PKW(pB1, 10), PKW(pB1, 12), PKW(pB1, 14)};
      SBAR(); pv(o, vb0 + sl_cur, PAF(0), PAF(1), PAF(2), PAF(3)); }
#undef PKW
#undef PAF
#undef VFR
#undef PIN
#undef MX3
#undef GAPA
#undef GAPB
#undef EX
#undef VRD
#undef KRD
#undef STEP
#undef ENDW
    { auto rr = __builtin_amdgcn_permlane32_swap(__float_as_uint(l_reg), __float_as_uint(l_reg), false, false); l_reg = __uint_as_float(rr[0]) + __uint_as_float(rr[1]); }
    if (hi == 0) wsf[32 + r32] = l_reg; asm volatile("s_waitcnt lgkmcnt(0)" ::: "memory");
    float rli[16];
#pragma unroll
    for (int r = 0; r < 16; ++r) rli[r] = __builtin_amdgcn_rcpf(wsf[32 + crow(r, hi)]);
    bf16* Ow = O + (rowbase + q0 + wid * QBLK) * DM + h * D;
    { bf16* stg = (bf16*)(shm + LDS_OST) + wid * 2048;
#pragma unroll
      for (int r = 0; r < 16; ++r) { const int orow = crow(r, hi);
#pragma unroll
          for (int d0 = 0; d0 < 2; ++d0) stg[orow * 64 + d0 * 32 + r32] = __float2bfloat16(o[d0][r] * rli[r]); }
      asm volatile("s_waitcnt lgkmcnt(0)" ::: "memory");
#pragma unroll
      for (int i = 0; i < 4; ++i) { const int row = i * 8 + (lane >> 3), ch = lane & 7; const u32x4 v = *(const u32x4*)(stg + row * 64 + ch * 8); *(u32x4*)(Ow + (long)row * DM + ch * 8) = v; } }
    asm volatile("s_waitcnt lgkmcnt(0)\n\ts_barrier" ::: "memory");
#undef DMA_K
#undef DMA_V
#undef DMA_M
#undef MINIT
#undef MWORD
#undef START
#undef RESC
#undef ROT
}
#undef SBAR
#undef WAIT_BAR
}

constexpr int RING_OFF = 0, RING_BYTES = 131072;
constexpr int LDSCTL_OFF = 139264, MISC_OFF = LDSCTL_OFF + 320;
constexpr int LDS_BYTES = 147456;
typedef GAS unsigned gu32;

#define XB_TMO      128
#define XB_XCNT(j)  (256  + 64 * (j))
#define XB_XSUB(j)  (1280 + 64 * (j))
#define XB_XGEN(j)  (2304 + 64 * (j))
#define XB_TOP      3328
#define XB_TOPGEN   3392
#define XCD_BAR_WORDS 3456
#define XB_SPIN_CAP (1u << 22)
__device__ __forceinline__ unsigned xb_ld(unsigned* p)              { return __hip_atomic_load(p, __ATOMIC_RELAXED, __HIP_MEMORY_SCOPE_AGENT); }
__device__ __forceinline__ unsigned xb_add(unsigned* p, unsigned v) { return __hip_atomic_fetch_add(p, v, __ATOMIC_RELAXED, __HIP_MEMORY_SCOPE_AGENT); }
__device__ __forceinline__ unsigned xb_xcc_id() { return (unsigned)__builtin_amdgcn_s_getreg((3 << 11) | 20) & 0xFu; }
#define XB_SPIN(cond, bar) do { unsigned _sp = 0; while (cond) { __builtin_amdgcn_s_sleep(1); \
    if ((++_sp & 255u) == 0u) { if (xb_ld(&(bar)[XB_TMO])) break; if (_sp > XB_SPIN_CAP) { atomicAdd(&(bar)[XB_TMO], 1u); break; } } } } while (0)
struct XcdBarrier { unsigned* bar; unsigned x; volatile LAS unsigned* st; };
__device__ __forceinline__ XcdBarrier xcd_barrier_post(unsigned* bar, volatile LAS unsigned* st) {
    XcdBarrier b; b.bar = bar; b.x = xb_xcc_id(); b.st = st;
    if (threadIdx.x == 0) (void)xb_add(&bar[XB_XCNT(b.x)], 1u);
    return b;
}
__device__ __forceinline__ void xcd_barrier_complete(unsigned* bar, unsigned x, unsigned& nloc, unsigned& nx) {
    const unsigned G = gridDim.x * gridDim.y * gridDim.z;
    unsigned sum, cnt, mine, sp = 0u;
    for (;;) {
        sum = 0u; cnt = 0u; mine = 0u;
#pragma unroll
        for (unsigned j = 0; j < 16; ++j) { const unsigned c = xb_ld(&bar[XB_XCNT(j)]); sum += c; cnt += (c > 0u) ? 1u : 0u; mine = (j == x) ? c : mine; }
        if (sum == G) break;
        __builtin_amdgcn_s_sleep(1);
        if ((++sp & 255u) == 0u) { if (xb_ld(&bar[XB_TMO])) break; if (sp > XB_SPIN_CAP) { atomicAdd(&bar[XB_TMO], 1u); break; } }
    }
    nloc = mine > 0u ? mine : 1u; nx = cnt > 0u ? cnt : 1u;
}
__device__ __forceinline__ void xcd_barrier(const XcdBarrier& b) {
    asm volatile("s_waitcnt vmcnt(0)" ::: "memory");
    __syncthreads();
    if (threadIdx.x == 0) {
        unsigned* bar = b.bar;
        __builtin_amdgcn_s_waitcnt(0);
        unsigned nloc = b.st[0], nx = b.st[1];
        if (nloc == 0u) { xcd_barrier_complete(bar, b.x, nloc, nx); b.st[0] = nloc; b.st[1] = nx; }
        const unsigned old = xb_add(&bar[XB_XSUB(b.x)], 1u);
        const unsigned gen = old / nloc;
        if (old + 1u == (gen + 1u) * nloc) {
            __builtin_amdgcn_fence(__ATOMIC_RELEASE, "agent");
            asm volatile("s_waitcnt vmcnt(0)" ::: "memory");
            const unsigned og = xb_add(&bar[XB_TOP], 1u);
            const unsigned tg = og / nx;
            if (og + 1u == (tg + 1u) * nx) xb_add(&bar[XB_TOPGEN], 1u);
            else XB_SPIN(xb_ld(&bar[XB_TOPGEN]) == tg, bar);
            __builtin_amdgcn_fence(__ATOMIC_ACQUIRE, "agent");
            xb_add(&bar[XB_XGEN(b.x)], 1u);
            asm volatile("s_waitcnt vmcnt(0)" ::: "memory");
        } else {
            XB_SPIN(xb_ld(&bar[XB_XGEN(b.x)]) == gen, bar);
            __builtin_amdgcn_fence(__ATOMIC_ACQUIRE, "agent");
            asm volatile("s_waitcnt vmcnt(0)" ::: "memory");
        }
    }
    __syncthreads();
}

struct Frame {
    LAS unsigned char* lds; unsigned char* ldsg;
    int tid, lane, wave, vcu, G;
    const float* in[13]; float* out; unsigned char* ws;
};

__device__ __forceinline__ int perm_part(int c) {
    const int hp = c & 63;
    if (hp >= 16) return c;
    const int q = hp >> 3, r = hp & 7;
    return (c & ~63) + ((r < 4) ? (4 * q + r) : (8 + 4 * q + (r - 4)));
}
__device__ __forceinline__ int win_src_col(int p) {
    const int tile = p >> 8, c = p & 255;
    if (tile <= 1) { const int head = (c & 127) >> 5, d = c & 31; return tile * 256 + head * 64 + ((c >= 128) ? 32 : 0) + d; }
    if (tile <= 5) return 512 + (tile - 2) * 256 + c;
    if (tile <= 9) return 1536 + (tile - 6) * 256 + perm_part(c);
    if (tile <= 11) return 2560 + (tile - 10) * 256 + c;
    if (tile == 12) return 3072 + perm_part(c);
    if (tile == 13) { if (c < 64) return 3328 + perm_part(c); if (c < 68) return 3392 + (c - 64); return -1; }
    return 3396 + (tile - 14) * 256 + c;
}
template <bool MAP> __device__ __forceinline__ void p0_transpose_item(const float* W, int K, int N, u16* WT, LAS float* scr, int item, int nblk, int lane, const float* gk = nullptr) {
    const int kb = item / nblk, nb = item % nblk, k0 = 64 * kb, n0 = 32 * nb;
    const int sc = MAP ? win_src_col(n0 + (lane & 31)) : (n0 + (lane & 31));
#pragma unroll
    for (int i = 0; i < 32; ++i) { const int kk = 2 * i + (lane >> 5); scr[kk * 33 + (lane & 31)] = (sc >= 0) ? W[(size_t)(k0 + kk) * N + sc] * (MAP ? gk[k0 + kk] : 1.0f) : 0.f; }
    LDS_WAIT(); asm volatile("" ::: "memory");
    const int c = lane & 7;
#pragma unroll
    for (int j = 0; j < 4; ++j) { const int n = (lane >> 3) + 8 * j; const LAS float* s = scr + (8 * c) * 33 + n;
        u32x4 o; o.x = f2bf(s[0 * 33]) | (f2bf(s[1 * 33]) << 16); o.y = f2bf(s[2 * 33]) | (f2bf(s[3 * 33]) << 16); o.z = f2bf(s[4 * 33]) | (f2bf(s[5 * 33]) << 16); o.w = f2bf(s[6 * 33]) | (f2bf(s[7 * 33]) << 16);
        *(u32x4*)(WT + (size_t)(n0 + n) * K + k0 + 8 * c) = o; }
    LDS_WAIT(); asm volatile("" ::: "memory");
}
__device__ __forceinline__ void p0_prologue(Frame& F) {
    const float* x = F.in[0]; const float* attn_norm = F.in[1]; const float* w_in = F.in[2];
    const float* w_ret_o = F.in[4]; const float* w_dsa_o = F.in[5]; const float* w_out = F.in[6]; const float* ffn_norm = F.in[7];
    const float* peer_wq = F.in[8]; const float* subkeys = F.in[9]; const float* peer_u = F.in[10]; const float* peer_v = F.in[11];
    unsigned char* ws = F.ws;
    {
        u16* WSC = (u16*)(ws + WS_WSC);
        const int lane = F.lane, l32 = lane & 31, hi = lane >> 5, ri = F.wave & 1, ci = F.wave >> 1;
        for (int item = F.vcu; item < 256; item += F.G) {
            const int blk = item >> 4, i0 = (item & 15) * 64 + 32 * ri, k0 = 32 * ci;
            const float* ap = peer_wq + (size_t)(i0 + l32) * 2048 + blk * 128 + 8 * hi;
            const float* bp = subkeys + (size_t)(blk * 128 + k0 + l32) * 128 + 8 * hi;
            f32x4 av[8][2], bv[8][2];
#pragma unroll
            for (int kk = 0; kk < 8; ++kk) { av[kk][0] = *(const f32x4*)(ap + 16 * kk); av[kk][1] = *(const f32x4*)(ap + 16 * kk + 4); bv[kk][0] = *(const f32x4*)(bp + 16 * kk); bv[kk][1] = *(const f32x4*)(bp + 16 * kk + 4); }
            f32x16 acc = {};
#pragma unroll
            for (int kk = 0; kk < 8; ++kk) {
                const u32x4 aw = {cvt_pk_bf16(av[kk][0][0], av[kk][0][1]), cvt_pk_bf16(av[kk][0][2], av[kk][0][3]), cvt_pk_bf16(av[kk][1][0], av[kk][1][1]), cvt_pk_bf16(av[kk][1][2], av[kk][1][3])};
                const u32x4 bw = {cvt_pk_bf16(bv[kk][0][0], bv[kk][0][1]), cvt_pk_bf16(bv[kk][0][2], bv[kk][0][3]), cvt_pk_bf16(bv[kk][1][0], bv[kk][1][1]), cvt_pk_bf16(bv[kk][1][2], bv[kk][1][3])};
                acc = __builtin_amdgcn_mfma_f32_32x32x16_bf16(__builtin_bit_cast(bf16x8, aw), __builtin_bit_cast(bf16x8, bw), acc, 0, 0, 0);
            }
#pragma unroll
            for (int q = 0; q < 4; ++q) { const int ib = i0 + 8 * q + 4 * hi; const f32x4 gn = *(const f32x4*)(ffn_norm + ib);
                u32x2 w; w.x = cvt_pk_bf16(acc[4 * q] * gn[0], acc[4 * q + 1] * gn[1]); w.y = cvt_pk_bf16(acc[4 * q + 2] * gn[2], acc[4 * q + 3] * gn[3]);
                *(u32x2*)(WSC + (size_t)sc_pos(blk * 128 + k0 + l32) * 1024 + ib) = w; }
        }
    }
    LAS float* scr = (LAS float*)(F.lds + F.wave * 16384);
    const int gw = F.vcu * NWAVES + F.wave, NGW = F.G * NWAVES;
    constexpr int I_IN = 16 * (N1PAD / 32), I_RO = 8 * 32, I_DO = 8 * 32, I_OUT = 16 * 32;
    constexpr int NITEMS = I_IN + I_RO + I_DO + I_OUT;
    for (int it = gw; it < NITEMS; it += NGW) {
        int r = it;
        if (r < I_IN) { p0_transpose_item<true>(w_in, 1024, D_IN, (u16*)(ws + WS_WIN), scr, r, N1PAD / 32, F.lane, attn_norm); continue; } r -= I_IN;
        if (r < I_RO) { p0_transpose_item<false>(w_ret_o, 512, 1024, (u16*)(ws + WS_WRO), scr, r, 32, F.lane); continue; } r -= I_RO;
        if (r < I_DO) { p0_transpose_item<false>(w_dsa_o, 512, 1024, (u16*)(ws + WS_WDO), scr, r, 32, F.lane); continue; } r -= I_DO;
        p0_transpose_item<false>(w_out, 1024, 1024, (u16*)(ws + WS_WOUT), scr, r, 32, F.lane);
    }
    {
        u16* H = (u16*)(ws + WS_XB); float* RS = (float*)(ws + WS_RSTD);
        for (int m0 = gw; m0 < NTOK; m0 += 2 * NGW) {
            const int m1 = (m0 + NGW < NTOK) ? m0 + NGW : m0;
            const f32x4* xr0 = (const f32x4*)(x + (size_t)m0 * DMODEL) + F.lane; const f32x4* xr1 = (const f32x4*)(x + (size_t)m1 * DMODEL) + F.lane;
            f32x4 v0[4], v1[4]; float s0 = 0.f, s1 = 0.f;
#pragma unroll
            for (int j = 0; j < 4; ++j) { v0[j] = xr0[64 * j]; v1[j] = xr1[64 * j]; }
#pragma unroll
            for (int j = 0; j < 4; ++j) { s0 += (v0[j].x * v0[j].x + v0[j].y * v0[j].y) + (v0[j].z * v0[j].z + v0[j].w * v0[j].w); s1 += (v1[j].x * v1[j].x + v1[j].y * v1[j].y) + (v1[j].z * v1[j].z + v1[j].w * v1[j].w); }
            const float rstd0 = 1.0f / sqrtf(wave_sum(s0) * (1.f / DMODEL) + EPS), rstd1 = 1.0f / sqrtf(wave_sum(s1) * (1.f / DMODEL) + EPS);
            u32x2* o0 = (u32x2*)(H + (size_t)m0 * DMODEL) + F.lane; u32x2* o1 = (u32x2*)(H + (size_t)m1 * DMODEL) + F.lane;
#pragma unroll
            for (int j = 0; j < 4; ++j) { u32x2 w; w.x = cvt_pk_bf16(v0[j].x, v0[j].y); w.y = cvt_pk_bf16(v0[j].z, v0[j].w); o0[64 * j] = w;
                u32x2 w2; w2.x = cvt_pk_bf16(v1[j].x, v1[j].y); w2.y = cvt_pk_bf16(v1[j].z, v1[j].w); o1[64 * j] = w2; }
            if (F.lane == 0) { RS[m0] = rstd0; RS[m1] = rstd1; }
        }
    }
    {
        const int gwv = F.vcu * NWAVES + F.wave, NWV = F.G * NWAVES;
        unsigned* KUV = (unsigned*)(ws + WS_KUV);
        for (int r = gwv; r < 16384; r += NWV) {
            f32x4 a[2][4];
#pragma unroll
            for (int u = 0; u < 2; ++u) { const float* src = (u ? peer_v : peer_u) + (size_t)r * 1024 + 4 * F.lane;
#pragma unroll
                for (int q = 0; q < 4; ++q) a[u][q] = *(const f32x4*)(src + 256 * q); }
            unsigned kk = 0;
#pragma unroll
            for (int u = 0; u < 2; ++u) {
                float m = 0.f;
#pragma unroll
                for (int q = 0; q < 4; ++q) m = fmaxf(fmaxf(m, fmaxf(fabsf(a[u][q][0]), fabsf(a[u][q][1]))), fmaxf(fabsf(a[u][q][2]), fabsf(a[u][q][3])));
                m = wave_max(m);
                const int eb = (int)((__float_as_uint(m) >> 23) & 0xffu);
                int k = eb ? 129 - eb : 0; k = k < -64 ? -64 : (k > 63 ? 63 : k);
                const float sc = __uint_as_float((unsigned)(127 + k) << 23);
                unsigned c[16];
#pragma unroll
                for (int q = 0; q < 4; ++q)
#pragma unroll
                    for (int j = 0; j < 4; ++j) c[4 * q + j] = fp6_code(a[u][q][j] * sc);
                U3 w;
                w.x = c[0] | (c[1] << 6) | (c[2] << 12) | (c[3] << 18) | (c[4] << 24) | (c[5] << 30);
                w.y = (c[5] >> 2) | (c[6] << 4) | (c[7] << 10) | (c[8] << 16) | (c[9] << 22) | (c[10] << 28);
                w.z = (c[10] >> 4) | (c[11] << 2) | (c[12] << 8) | (c[13] << 14) | (c[14] << 20) | (c[15] << 26);
                *(U3*)(ws + (u ? WS_V : WS_U) + (size_t)r * 768 + 12 * F.lane) = w;
                kk |= (unsigned)(k + 64) << (8 * u);
            }
            if (F.lane == 0) KUV[r] = kk;
        }
        const size_t gt = (size_t)F.vcu * 512 + F.tid, NT_ = (size_t)F.G * 512;
        f32x2* ta = (f32x2*)(ws + WS_TABA); f32x2* tb = (f32x2*)(ws + WS_TABB);
        for (size_t i = gt; i < (size_t)SEQ * 40; i += NT_) {
            const int pos = (int)(i / 40), k = (int)(i % 40);
            const float inv = (k < 32) ? exp2f(-(float)k * (13.287712379549449f / 32.0f)) : exp2f(-(float)(k - 32) * (18.931568569324174f / 8.0f));
            const float ang = (float)pos * inv;
            float sn_, cs_; sincosf(ang, &sn_, &cs_);
            const f32x2 cs = {cs_, sn_};
            if (k < 32) ta[pos * 32 + k] = cs; else tb[pos * 8 + (k - 32)] = cs;
        }
    }
}

__device__ __forceinline__ float ret_logg(int h) { return logf(1.0f - exp2f(-5.0f - (float)h)); }
constexpr int RS_K = 72, RS_V = 160;
__device__ __forceinline__ bf16x8 gather8(const LAS u16* p, int stride) {
    bf16x8 v;
#pragma unroll
    for (int i = 0; i < 8; ++i) v[i] = (short)p[i * stride];
    return v;
}
__device__ __forceinline__ bf16x8 tr_frag(const LAS u16* tile, int rs, int k0, int n0, int lane) {
    const LAS u16* a = tile + (k0 + 8 * (lane >> 5) + ((lane & 15) >> 2)) * rs + n0 + 16 * ((lane >> 4) & 1) + 4 * (lane & 3);
    const s16x4 lo = attn_body::vtr((attn_body::lds_cptr)a), hi = attn_body::vtr((attn_body::lds_cptr)(a + 4 * rs));
    return (bf16x8){lo[0], lo[1], lo[2], lo[3], hi[0], hi[1], hi[2], hi[3]};
}
__device__ __forceinline__ int ret_item(int g, int i) { return ((((g >> 6) * 128 + ((g >> 2) & 15) * 8 + i) << 2) | (g & 3)); }
struct KvIn { u32x4 k, v[2]; };
__device__ __forceinline__ void ret_kv_load(Frame& F, int item, KvIn& I) {
    const int h = item & 3, bn = item >> 2;
    const u16* RKp = (const u16*)(F.ws + WS_RK) + (size_t)bn * 64 * 256 + h * 64;
    const u16* RVp = (const u16*)(F.ws + WS_RV) + (size_t)bn * 64 * 512 + h * 128;
    { const int j = F.tid >> 3, c = (F.tid & 7) * 8; I.k = *(const u32x4*)(RKp + (size_t)j * 256 + c); }
#pragma unroll
    for (int i = 0; i < 2; ++i) { const int e = F.tid + 512 * i; const int j = e >> 4, c = (e & 15) * 8; I.v[i] = *(const u32x4*)(RVp + (size_t)j * 512 + c); }
}
__device__ __forceinline__ u32x4 ret_scale_k(const u32x4 k4, float dec) {
    const unsigned w[4] = {k4.x, k4.y, k4.z, k4.w}; unsigned r[4];
#pragma unroll
    for (int q = 0; q < 4; ++q) r[q] = cvt_pk_bf16(bf2f(w[q] & 0xffffu) * dec, bf2f(w[q] >> 16) * dec);
    u32x4 o; o.x = r[0]; o.y = r[1]; o.z = r[2]; o.w = r[3]; return o;
}
__device__ __forceinline__ void ret_kv_group(Frame& F, int g) {
    const int h = g & 3;
    float* gap = (float*)((unsigned char*)F.out + OUT_KV) + (size_t)g * 8192;
    const float lg = ret_logg(h), cd = __expf(lg * 64.0f);
    const int td = F.wave >> 2, te = F.wave & 3, r32 = F.lane & 31, hi = F.lane >> 5;
    KvIn I; ret_kv_load(F, ret_item(g, 0), I);
    f32x16 acc = {};
#pragma unroll 1
    for (int i = 0; i < 8; ++i) {
        LAS u16* Ks = (LAS u16*)(F.lds + (i & 1) * 32768); LAS u16* Vs = Ks + 64 * RS_K;
        { const int j = F.tid >> 3, c = (F.tid & 7) * 8;
          *(LAS u32x4*)(Ks + j * RS_K + c) = ret_scale_k(I.k, __expf(lg * (float)(63 - j))); }
#pragma unroll
        for (int q = 0; q < 2; ++q) { const int e = F.tid + 512 * q; const int j = e >> 4, c = (e & 15) * 8;
          *(LAS u32x4*)(Vs + j * RS_V + c) = I.v[q]; }
        LDS_WAIT(); __builtin_amdgcn_s_barrier();
        if (i < 7) ret_kv_load(F, ret_item(g, i + 1), I);
#pragma unroll
        for (int r = 0; r < 16; ++r) acc[r] *= cd;
#pragma unroll
        for (int kk = 0; kk < 4; ++kk) {
            const bf16x8 a = tr_frag(Ks, RS_K, 16 * kk, 32 * td, F.lane);
            const bf16x8 bb = tr_frag(Vs, RS_V, 16 * kk, 32 * te, F.lane);
            acc = __builtin_amdgcn_mfma_f32_32x32x16_bf16(a, bb, acc, 0, 0, 0);
        }
    }
#pragma unroll
    for (int r = 0; r < 16; ++r) { const int d = 32 * td + (r & 3) + 8 * (r >> 2) + 4 * hi; gap[d * 128 + 32 * te + r32] = acc[r]; }
    LDS_WAIT(); __builtin_amdgcn_s_barrier();
}
__device__ __forceinline__ void ret_scan(Frame& F) {
    float* kv = (float*)((unsigned char*)F.out + OUT_KV);
    for (int idx = F.vcu * 512 + F.tid; idx < 16 * 8192; idx += F.G * 512) {
        const int bh = idx >> 13, de = idx & 8191, b = bh >> 2, h = bh & 3;
        const float cd8 = __expf(ret_logg(h) * 512.0f);
        float* p = kv + ((size_t)(b * 16) * 4 + h) * 8192 + de;
        float t[16]; float s = 0.f;
#pragma unroll
        for (int n = 0; n < 16; ++n) t[n] = p[(size_t)n * 4 * 8192];
#pragma unroll
        for (int n = 0; n < 16; ++n) { p[(size_t)n * 4 * 8192] = s; s = cd8 * s + t[n]; }
    }
}
struct OutIn { u32x4 q, k, v[2]; };
__device__ __forceinline__ void ret_out_load(Frame& F, int item, OutIn& I) {
    const int h = item & 3, bn = item >> 2; const size_t tok0 = (size_t)bn * 64;
    const u16* RQp = (const u16*)(F.ws + WS_RQ) + tok0 * 256 + h * 64; const u16* RKp = (const u16*)(F.ws + WS_RK) + tok0 * 256 + h * 64;
    const u16* RVp = (const u16*)(F.ws + WS_RV) + tok0 * 512 + h * 128;
    { const int j = F.tid >> 3, c = (F.tid & 7) * 8; I.q = *(const u32x4*)(RQp + (size_t)j * 256 + c); I.k = *(const u32x4*)(RKp + (size_t)j * 256 + c); }
#pragma unroll
    for (int i = 0; i < 2; ++i) { const int e = F.tid + 512 * i; const int j = e >> 4, c = (e & 15) * 8; I.v[i] = *(const u32x4*)(RVp + (size_t)j * 512 + c); }
}
__device__ __forceinline__ void ret_out_item(Frame& F, int item, OutIn& I, int nxt, f32x16& st, float cd) {
    const int h = item & 3, bn = item >> 2;
    const size_t tok0 = (size_t)bn * 64;
    const u16* RGp = (const u16*)(F.ws + WS_RG) + tok0 * 512 + h * 128;
    const float* gn = F.in[3] + h * 128;
    u16* YR = (u16*)(F.ws + WS_YRET) + tok0 * 512 + h * 128;
    LAS u16* Qs = (LAS u16*)F.lds; LAS u16* K2 = Qs + 64 * RS_K; LAS u16* Vs = K2 + 64 * RS_K; LAS u16* PsT = Vs + 64 * RS_V;
    LAS u16* Sw = PsT + 128 * RS_K + F.wave * (32 * RS_K); LAS float* Ys = (LAS float*)(PsT + 128 * RS_K + 8 * 32 * RS_K);
    float lg = ret_logg(h);
    asm volatile("" : "+v"(lg));
    const int ti = F.wave >> 2, te = F.wave & 3, r32 = F.lane & 31, hi = F.lane >> 5;
    { const int j = F.tid >> 3, c = (F.tid & 7) * 8;
      *(LAS u32x4*)(Qs + j * RS_K + c) = I.q;
      *(LAS u32x4*)(K2 + j * RS_K + c) = ret_scale_k(I.k, __expf(lg * (float)(63 - j))); }
#pragma unroll
    for (int i = 0; i < 2; ++i) { const int e = F.tid + 512 * i; const int j = e >> 4, c = (e & 15) * 8;
      *(LAS u32x4*)(Vs + j * RS_V + c) = I.v[i]; }
#pragma unroll
    for (int g4 = 0; g4 < 4; ++g4) {
        u32x2 w; w.x = cvt_pk_bf16(st[4 * g4], st[4 * g4 + 1]); w.y = cvt_pk_bf16(st[4 * g4 + 2], st[4 * g4 + 3]);
        *(LAS u32x2*)(PsT + (32 * te + r32) * RS_K + 32 * ti + 8 * g4 + 4 * hi) = w; }
    LDS_WAIT(); __builtin_amdgcn_s_barrier();
    if (nxt >= 0) ret_out_load(F, nxt, I);
#pragma unroll
    for (int tj = 0; tj < 2; ++tj) {
        f32x16 s = {};
#pragma unroll
        for (int kk = 0; kk < 4; ++kk) {
            const bf16x8 a = *(const LAS bf16x8*)(Qs + (32 * ti + r32) * RS_K + 16 * kk + 8 * hi);
            const bf16x8 bb = *(const LAS bf16x8*)(K2 + (32 * tj + r32) * RS_K + 16 * kk + 8 * hi);
            s = __builtin_amdgcn_mfma_f32_32x32x16_bf16(a, bb, s, 0, 0, 0);
        }
#pragma unroll
        for (int r = 0; r < 16; ++r) { const int il = (r & 3) + 8 * (r >> 2) + 4 * hi; const int dd = (32 * ti + il) - (32 * tj + r32);
            Sw[il * RS_K + 32 * tj + r32] = (u16)f2bf(s[r] * __expf(lg * (fabsf((float)dd) - (float)(63 - (32 * tj + r32))))); }
    }
    LDS_WAIT();
    f32x16 y = {}, cr = {};
#pragma unroll
    for (int r = 0; r < 16; ++r) st[r] *= cd;
#pragma unroll
    for (int kk = 0; kk < 4; ++kk) {
        const bf16x8 a = *(const LAS bf16x8*)(Sw + r32 * RS_K + 16 * kk + 8 * hi);
        const bf16x8 bb = tr_frag(Vs, RS_V, 16 * kk, 32 * te, F.lane);
        y = __builtin_amdgcn_mfma_f32_32x32x16_bf16(a, bb, y, 0, 0, 0);
        const bf16x8 a2 = *(const LAS bf16x8*)(Qs + (32 * ti + r32) * RS_K + 16 * kk + 8 * hi);
        const bf16x8 b2 = *(const LAS bf16x8*)(PsT + (32 * te + r32) * RS_K + 16 * kk + 8 * hi);
        cr = __builtin_amdgcn_mfma_f32_32x32x16_bf16(a2, b2, cr, 0, 0, 0);
        const bf16x8 a3 = tr_frag(K2, RS_K, 16 * kk, 32 * ti, F.lane);
        st = __builtin_amdgcn_mfma_f32_32x32x16_bf16(a3, bb, st, 0, 0, 0);
    }
#pragma unroll
    for (int r = 0; r < 16; ++r) { const int i = 32 * ti + (r & 3) + 8 * (r >> 2) + 4 * hi;
        Ys[i * 132 + 32 * te + r32] = y[r] + cr[r] * __expf(lg * (float)(i + 1)); }

    LDS_WAIT(); __builtin_amdgcn_s_barrier();
    { const int i = F.tid >> 3, sg = (F.tid & 7) * 16;
      float v[16]; float s = 0.f;
#pragma unroll
      for (int q = 0; q < 4; ++q) { const f32x4 t = *(const LAS f32x4*)(Ys + i * 132 + sg + 4 * q); v[4 * q] = t[0]; v[4 * q + 1] = t[1]; v[4 * q + 2] = t[2]; v[4 * q + 3] = t[3]; s += (t[0] + t[1]) + (t[2] + t[3]); }
      s += dppf<0xB1>(s); s += dppf<0x4E>(s); s += dppf<0x141>(s);
      const float mu = s * (1.f / 128.f); float q2 = 0.f;
#pragma unroll
      for (int q = 0; q < 16; ++q) { v[q] -= mu; q2 += v[q] * v[q]; }
      q2 += dppf<0xB1>(q2); q2 += dppf<0x4E>(q2); q2 += dppf<0x141>(q2);
      const float rstd = 1.0f / sqrtf(q2 * (1.f / 128.f) + EPS);
      const u32x4 g0 = *(const u32x4*)(RGp + (size_t)i * 512 + sg), g1 = *(const u32x4*)(RGp + (size_t)i * 512 + sg + 8);
      const unsigned gw_[8] = {g0.x, g0.y, g0.z, g0.w, g1.x, g1.y, g1.z, g1.w};
      unsigned ow[8];
#pragma unroll
      for (int q = 0; q < 8; ++q) { const float a = v[2 * q] * rstd * gn[sg + 2 * q] * bf2f(gw_[q] & 0xffffu), bq = v[2 * q + 1] * rstd * gn[sg + 2 * q + 1] * bf2f(gw_[q] >> 16); ow[q] = cvt_pk_bf16(a, bq); }
      *(u32x4*)(YR + (size_t)i * 512 + sg) = (u32x4){ow[0], ow[1], ow[2], ow[3]}; *(u32x4*)(YR + (size_t)i * 512 + sg + 8) = (u32x4){ow[4], ow[5], ow[6], ow[7]}; }
}
__device__ __forceinline__ void ret_out_group(Frame& F, int g) {
    const int h = g & 3;
    const float* gsp = (const float*)((unsigned char*)F.out + OUT_KV) + (size_t)g * 8192;
    const float cd = __expf(ret_logg(h) * 64.0f);
    const int td = F.wave >> 2, te = F.wave & 3, r32 = F.lane & 31, hi = F.lane >> 5;
    OutIn I; ret_out_load(F, ret_item(g, 0), I);
    f32x16 st;
#pragma unroll
    for (int r = 0; r < 16; ++r) { const int d = 32 * td + (r & 3) + 8 * (r >> 2) + 4 * hi; st[r] = gsp[d * 128 + 32 * te + r32]; }
#pragma unroll 1
    for (int i = 0; i < 8; ++i) ret_out_item(F, ret_item(g, i), I, i < 7 ? ret_item(g, i + 1) : -1, st, cd);
}

__device__ __forceinline__ void bt16(unsigned (&x)[16]) {
#pragma unroll
    for (int j = 0; j < 8; ++j) { const unsigned a = x[j], b = x[j + 8]; x[j] = __builtin_amdgcn_perm(b, a, 0x06020400u); x[j + 8] = __builtin_amdgcn_perm(b, a, 0x07030501u); }
#define BT_STAGE(s, m) _Pragma("unroll") for (int j = 0; j < 16; ++j) if (!(j & s)) { const unsigned a = x[j], b = x[j + s]; x[j] = (a & m) | ((b << s) & ~m); x[j + s] = ((a >> s) & m) | (b & ~m); }
    BT_STAGE(4, 0x0F0F0F0Fu) BT_STAGE(2, 0x33333333u) BT_STAGE(1, 0x55555555u)
#undef BT_STAGE
}
__device__ __forceinline__ float relu_s(float x) { return __builtin_amdgcn_fmed3f(x, 0.0f, 3.0e38f); }
constexpr int IDX_WST = 131072;
struct IdxPre { f16x8 qa[4]; f32x4 wv[4]; f16x8 b0[2][4], b1[2][4]; };
__device__ __forceinline__ void idx_prefetch(Frame& F, int grp, IdxPre& P) {
    const int b = grp >> 10, t0 = (grp & 1023) * 8, ntile32 = 2 * ((t0 >> 6) + 1);
    const size_t tokbase = (size_t)b * SEQ;
    const int lane = F.lane, wid = F.wave, r32 = lane & 31, hi = lane >> 5;
    const _Float16* IQ = (const _Float16*)(F.ws + WS_IQ); const _Float16* IK = (const _Float16*)(F.ws + WS_IK); const float* IW = (const float*)(F.ws + WS_IW);
    const _Float16* qp = IQ + (tokbase + t0 + (r32 >> 2)) * 256 + (r32 & 3) * 64 + 8 * hi;
#pragma unroll
    for (int kk = 0; kk < 4; ++kk) P.qa[kk] = *(const f16x8*)(qp + 16 * kk);
#pragma unroll
    for (int jq = 0; jq < 4; ++jq) P.wv[jq] = *(const f32x4*)(IW + (tokbase + t0 + 2 * jq + hi) * 4) * 1024.0f;
#pragma unroll
    for (int u = 0; u < 2; ++u) {
        const int Ta_ = wid + NWAVES * u, Tb_ = wid + NWAVES * (2 + u);
        const int Ta = Ta_ < ntile32 ? Ta_ : ntile32 - 1, Tb = Tb_ < ntile32 ? Tb_ : ntile32 - 1;
        const _Float16* ka = IK + ((tokbase >> 5) + Ta) * 2048 + lane * 8; const _Float16* kb = IK + ((tokbase >> 5) + Tb) * 2048 + lane * 8;
#pragma unroll
        for (int kk = 0; kk < 4; ++kk) { P.b0[u][kk] = *(const f16x8*)(ka + 512 * kk); P.b1[u][kk] = *(const f16x8*)(kb + 512 * kk); }
    }
}
__device__ __forceinline__ void indexer_group(Frame& F, int grp, int nxt, IdxPre& P) {
    const int b = grp >> 10, g8 = grp & 1023, t0 = g8 * 8, chunk = t0 >> 6, nt64 = chunk + 1;
    const size_t tokbase = (size_t)b * SEQ;
    const int nwords = 4 * (chunk >> 2) + 4;
    unsigned long long* BMp = (unsigned long long*)((unsigned char*)F.out + OUT_BM);
    LAS u16* sc = (LAS u16*)F.lds;
    LAS unsigned long long* wst = (LAS unsigned long long*)(F.lds + IDX_WST);
    const int lane = F.lane, wid = F.wave, r32 = lane & 31, hi = lane >> 5;
    if (nt64 <= 4) {
        if (F.tid < nwords * 4) { const int i = F.tid >> 2, part = F.tid & 3; const unsigned long long w = (i < nt64) ? ~0ull : 0ull;
            unsigned long long* dst = BMp + ((size_t)(b * 128 + i) * SEQ + t0 + 2 * part); dst[0] = w; dst[1] = w; }
        idx_prefetch(F, nxt, P);
        return;
    }
    {
        const _Float16* IK = (const _Float16*)(F.ws + WS_IK);
        f16x8 (&qa)[4] = P.qa; f32x4 (&wv)[4] = P.wv;
        const int ntile32 = nt64 * 2;
        const int rotl = 2 * (r32 & 15) + hi, lofs = hi * 8192 + (r32 & 15) * 128 + (r32 >> 4);
#define IDX_LOAD(buf, trip) do { _Pragma("unroll") for (int u = 0; u < 2; ++u) { const int T_ = wid + NWAVES * (2 * (trip) + u); const int T = T_ < ntile32 ? T_ : ntile32 - 1; { const _Float16* kp = IK + ((tokbase >> 5) + T) * 2048 + lane * 8; \
            _Pragma("unroll") for (int kk = 0; kk < 4; ++kk) buf[u][kk] = *(const f16x8*)(kp + 512 * kk); } } } while (0)
#define IDX_COMP(buf, trip) do { _Pragma("unroll") for (int u = 0; u < 2; ++u) { const int T_ = wid + NWAVES * (2 * (trip) + u); const int T = T_ < ntile32 ? T_ : ntile32 - 1; { \
            f32x16 acc = {}; \
            __builtin_amdgcn_s_setprio(1); \
            _Pragma("unroll") for (int kk = 0; kk < 4; ++kk) acc = __builtin_amdgcn_mfma_f32_32x32x16_f16(qa[kk], buf[u][kk], acc, 0, 0, 0); \
            __builtin_amdgcn_s_setprio(0); \
            const int wofs = (((T >> 6) * 16 * 64 + (((T & 63) + rotl) & 63)) << 1) + lofs;        \
            _Pragma("unroll") for (int jq = 0; jq < 4; ++jq) { \
                float s = __builtin_fmaf(wv[jq][0], relu_s(acc[4 * jq]), 49152.0f); \
                s = __builtin_fmaf(wv[jq][1], relu_s(acc[4 * jq + 1]), s); s = __builtin_fmaf(wv[jq][2], relu_s(acc[4 * jq + 2]), s); s = __builtin_fmaf(wv[jq][3], relu_s(acc[4 * jq + 3]), s); \
                  \
                const unsigned kq = (unsigned)__builtin_amdgcn_fmed3f(s, 32768.0f, 65535.0f);        \
                sc[2 * jq * 8192 + wofs] = (u16)kq; } } } } while (0)
        {
            const int ntrips = (ntile32 + 2 * NWAVES - 1) / (2 * NWAVES);
            f16x8 (&b0)[2][4] = P.b0; f16x8 (&b1)[2][4] = P.b1; f16x8 b2[2][4];
            {
            for (int i = 0; i < ntrips; i += 3) {
                IDX_LOAD(b2, i + 2); IDX_COMP(b0, i);
                if (i + 1 >= ntrips) break;
                IDX_LOAD(b0, i + 3); IDX_COMP(b1, i + 1);
                if (i + 2 >= ntrips) break;
                IDX_LOAD(b1, i + 4); IDX_COMP(b2, i + 2);
            }
            }
        }
#undef IDX_LOAD
#undef IDX_COMP
    }
    idx_prefetch(F, nxt, P);
    LDS_WAIT(); __builtin_amdgcn_s_barrier();
    {
        const int nblk = 2 * nt64;
        const LAS unsigned* row = (const LAS unsigned*)(sc + wid * 8192);
        unsigned P[4][16];
#pragma unroll
        for (int c = 0; c < 4; ++c) {
            if (c * 64 < nblk) {
                const bool valid = c * 64 + lane < nblk;
#pragma unroll
                for (int j = 0; j < 16; ++j) { const unsigned v = row[(c * 16 + j) * 64 + ((lane + 2 * j + (wid & 1)) & 63)]; P[c][j] = valid ? v : 0u; }
                bt16(P[c]);
            } else {
#pragma unroll
                for (int j = 0; j < 16; ++j) P[c][j] = 0u;
            }
        }
        unsigned A[4], G[4];
#pragma unroll
        for (int c = 0; c < 4; ++c) { A[c] = P[c][15]; G[c] = 0u; }
        int cntG = 0;
#pragma unroll
        for (int bit = 14; bit >= 0; --bit) {
            unsigned t[4]; int n = 0;
#pragma unroll
            for (int c = 0; c < 4; ++c) { t[c] = A[c] & P[c][bit]; n += (int)__builtin_popcount(t[c]); }
            const int n1 = __builtin_amdgcn_readfirstlane(wave_sum_i(n));
            if (cntG + n1 >= 256) {
#pragma unroll
                for (int c = 0; c < 4; ++c) A[c] = t[c];
            } else {
#pragma unroll
                for (int c = 0; c < 4; ++c) { G[c] |= t[c]; A[c] ^= t[c]; }
                cntG += n1;
            }
        }
        const int need = 256 - cntG;
        int na = 0;
#pragma unroll
        for (int c = 0; c < 4; ++c) na += (int)__builtin_popcount(A[c]);
        const int ntie = __builtin_amdgcn_readfirstlane(wave_sum_i(na));
        if (ntie > need) {
            int run = 0;
#pragma unroll
            for (int c = 0; c < 4; ++c) {
                const int pc = (int)__builtin_popcount(A[c]);
                int incl = pc;
#pragma unroll
                for (int o = 1; o < 64; o <<= 1) { const int v = __shfl_up(incl, o); if (lane >= o) incl += v; }
                int k = need - (run + incl - pc); k = k < 0 ? 0 : k;
                unsigned av = A[c];
                while ((int)__builtin_popcount(av) > k) av &= ~(0x80000000u >> __builtin_clz(av));
                A[c] = av;
                run += __builtin_amdgcn_readlane(incl, 63);
            }
        }
        LAS unsigned* wst32 = (LAS unsigned*)wst;
#pragma unroll
        for (int c = 0; c < 4; ++c) wst32[((c * 32 + (lane >> 1)) * 8 + wid) * 2 + (lane & 1)] = G[c] | A[c];
    }
    LDS_WAIT(); __builtin_amdgcn_s_barrier();
    if (F.tid < nwords * 4) { const int i = F.tid >> 2, part = F.tid & 3;
        const unsigned long long a = wst[i * 8 + 2 * part], c = wst[i * 8 + 2 * part + 1];
        unsigned long long* dst = BMp + ((size_t)(b * 128 + i) * SEQ + t0 + 2 * part); dst[0] = a; dst[1] = c; }
}

__device__ __forceinline__ float dot2bf(unsigned a, unsigned b, float c) { return __builtin_amdgcn_fdot2_f32_bf16(__builtin_bit_cast(bf16x2v, a), __builtin_bit_cast(bf16x2v, b), c, false); }
__device__ __forceinline__ unsigned f16key(unsigned bits) { return (bits & 0x8000u) ? (~bits & 0xffffu) : (bits | 0x8000u); }
__device__ __forceinline__ float f16key_val(unsigned key) { const unsigned bits = (key & 0x8000u) ? (key & 0x7fffu) : (~key & 0xffffu); return (float)__builtin_bit_cast(_Float16, (u16)bits); }
__device__ __forceinline__ unsigned f32key(float f) { const unsigned u = __builtin_bit_cast(unsigned, f); return (u & 0x80000000u) ? ~u : (u | 0x80000000u); }
#define CE(a, b) do { const unsigned _x = a > b ? a : b, _y = a > b ? b : a; a = _x; b = _y; } while (0)
__device__ __forceinline__ void top16_of_128(const u32x4 raw, int li, float& val, int& idx) {
    unsigned e[8];
    const unsigned w[4] = {raw.x, raw.y, raw.z, raw.w};
#pragma unroll
    for (int q = 0; q < 4; ++q) { e[2 * q] = (f16key(w[q] & 0xffffu) << 16) | (unsigned)(li * 8 + 2 * q); e[2 * q + 1] = (f16key(w[q] >> 16) << 16) | (unsigned)(li * 8 + 2 * q + 1); }
    CE(e[0], e[1]); CE(e[2], e[3]); CE(e[4], e[5]); CE(e[6], e[7]);
    CE(e[0], e[2]); CE(e[1], e[3]); CE(e[4], e[6]); CE(e[5], e[7]);
    CE(e[1], e[2]); CE(e[5], e[6]); CE(e[0], e[4]); CE(e[3], e[7]);
    CE(e[1], e[5]); CE(e[2], e[6]);
    CE(e[1], e[4]); CE(e[3], e[6]);
    CE(e[2], e[4]); CE(e[3], e[5]);
    CE(e[3], e[4]);
    unsigned mine = 0;
#pragma unroll
    for (int r = 0; r < 16; ++r) {
        const unsigned M = row16_maxu(e[0]);
        if (li == r) mine = M;
        if (e[0] == M) { e[0] = e[1]; e[1] = e[2]; e[2] = e[3]; e[3] = e[4]; e[4] = e[5]; e[5] = e[6]; e[6] = e[7]; e[7] = 0u; }
    }
    val = f16key_val(mine >> 16); idx = (int)(mine & 127u);
}
constexpr int PEER_T = 4;
constexpr int PEER_NSL = 16;
constexpr int PEER_SLSH = 10;
constexpr int PEER_WSC = 1024 + 256 + PEER_T * (1024 + 2048);
__device__ __forceinline__ void peer_select16(const _Float16* SCp, int lane, LAS unsigned* sel) {
    typedef short s16x2_t __attribute__((ext_vector_type(2)));
    const int p = lane & 3;
    unsigned D[16];
    { const u32x4* src = (const u32x4*)SCp + lane;
#pragma unroll
      for (int q = 0; q < 4; ++q) { const u32x4 v = src[64 * q]; D[4 * q] = v.x; D[4 * q + 1] = v.y; D[4 * q + 2] = v.z; D[4 * q + 3] = v.w; } }
#pragma unroll
    for (int i = 0; i < 16; ++i) { const s16x2_t h = __builtin_bit_cast(s16x2_t, D[i]); const s16x2_t sh = {15, 15};
        D[i] ^= (__builtin_bit_cast(unsigned, h >> sh) | 0x80008000u); }
    unsigned X[16];
#pragma unroll
    for (int j = 0; j < 16; ++j) X[j] = __builtin_amdgcn_perm(D[8 + (j >> 1)], D[j >> 1], (j & 1) ? 0x07060302u : 0x05040100u);
    bt16(X);
    unsigned A = ~0u, G = 0u; int cntG = 0;
#pragma unroll
    for (int b = 15; b >= 0; --b) {
        const unsigned t = A & X[b]; int n = (int)__builtin_popcount(t);
        n += dppi<0xB1>(n); n += dppi<0x4E>(n);
        const bool take = cntG + n >= 16;
        A = take ? t : (A ^ t); G = take ? G : (G | t); cntG = take ? cntG : cntG + n;
    }
    { const int tc = (int)__builtin_popcount(A);
      const int t0 = dppi<0x00>(tc), t1 = dppi<0x55>(tc), t2 = dppi<0xAA>(tc);
      const int ex = (p > 0 ? t0 : 0) + (p > 1 ? t1 : 0) + (p > 2 ? t2 : 0);
      int k = 16 - cntG - ex; k = k < 0 ? 0 : (k > tc ? tc : k);
      while ((int)__builtin_popcount(A) > k) A &= ~(0x80000000u >> __builtin_clz(A)); }
    unsigned S = G | A;
    { const int sc = (int)__builtin_popcount(S);
      const int t0 = dppi<0x00>(sc), t1 = dppi<0x55>(sc), t2 = dppi<0xAA>(sc);
      int pos = (lane >> 2) * 16 + (p > 0 ? t0 : 0) + (p > 1 ? t1 : 0) + (p > 2 ? t2 : 0);
      while (S) { const int m = __builtin_ctz(S); S &= S - 1u; sel[pos] = (unsigned)(32 * p + m); ++pos; } }
}
__device__ __forceinline__ void peer_route(Frame& F, int tok, LAS float* wsc, LAS float* tls, int& cvec) {
    const int lane = F.lane, gq = lane >> 4, li = lane & 15;
    const float* ffn_norm = F.in[7];
    const u16* xrow = (const u16*)(F.ws + WS_X1B) + (size_t)tok * DMODEL;
    const _Float16* SCp = (const _Float16*)(F.ws + WS_SC) + (size_t)tok * 2048;
    f32x4 xv[4]; float ss = 0.f;
    { unsigned w[8];
#pragma unroll
      for (int q = 0; q < 4; ++q) { const u32x2 t = *(const u32x2*)(xrow + 256 * q + 4 * lane); w[2 * q] = t.x; w[2 * q + 1] = t.y; }
#pragma unroll
      for (int q = 0; q < 4; ++q) { xv[q][0] = bf2f(w[2 * q] & 0xffffu); xv[q][1] = bf2f(w[2 * q] >> 16); xv[q][2] = bf2f(w[2 * q + 1] & 0xffffu); xv[q][3] = bf2f(w[2 * q + 1] >> 16); } }
#pragma unroll
    for (int q = 0; q < 4; ++q) ss += (xv[q][0] * xv[q][0] + xv[q][1] * xv[q][1]) + (xv[q][2] * xv[q][2] + xv[q][3] * xv[q][3]);
    const float rstd2 = 1.0f / sqrtf(wave_sum(ss) * (1.f / DMODEL) + EPS);
#pragma unroll
    for (int q = 0; q < 4; ++q) { const f32x4 g = *(const f32x4*)(ffn_norm + 256 * q + 4 * lane);
        ((LAS unsigned*)tls)[256 + (2 * q) * 64 + lane] = cvt_pk_bf16(xv[q][0] * rstd2 * g[0], xv[q][1] * rstd2 * g[1]); ((LAS unsigned*)tls)[256 + (2 * q + 1) * 64 + lane] = cvt_pk_bf16(xv[q][2] * rstd2 * g[2], xv[q][3] * rstd2 * g[3]); }
    int ex[2]; float gt[2]; unsigned exk[2];
    LAS float* aval = wsc; LAS int* aidx = (LAS int*)(wsc + 64); LAS float* bval = wsc + 128; LAS int* bidx = (LAS int*)(wsc + 192);
    const int ci2 = li <= 6 ? 1 : (li <= 10 ? 2 : (li <= 13 ? 3 : 4)), cj2 = li <= 6 ? li + 1 : (li <= 10 ? li - 6 : (li <= 13 ? li - 10 : li - 13));
    LAS unsigned* sel = (LAS unsigned*)tls;
    peer_select16(SCp, lane, sel);
    LDS_WAIT();
#pragma unroll
    for (int R = 0; R < 2; ++R) {
        const int hh = 4 * R + gq;
        const int rb16 = gq * 16;
        float av, bv; int ai, bi;
        {
            const int ia = (int)sel[(2 * hh) * 16 + li], ib = (int)sel[(2 * hh + 1) * 16 + li];
            const unsigned sa = ((const u16*)SCp)[sc_pos((2 * hh) * 128 + ia)], sb = ((const u16*)SCp)[sc_pos((2 * hh + 1) * 128 + ib)];
            const unsigned ka = (f16key(sa) << 16) | (unsigned)ia, kb = (f16key(sb) << 16) | (unsigned)ib;
            int ra_ = 0, rb_ = 0;
#define PEER_ROT(sft) { const unsigned xa = (unsigned)dppi<0x120 + sft>((int)ka), xb = (unsigned)dppi<0x120 + sft>((int)kb); ra_ += xa > ka ? 1 : 0; rb_ += xb > kb ? 1 : 0; }
            PEER_ROT(1) PEER_ROT(2) PEER_ROT(3) PEER_ROT(4) PEER_ROT(5) PEER_ROT(6) PEER_ROT(7) PEER_ROT(8) PEER_ROT(9) PEER_ROT(10) PEER_ROT(11) PEER_ROT(12) PEER_ROT(13) PEER_ROT(14) PEER_ROT(15)
#undef PEER_ROT
            aval[rb16 + ra_] = f16key_val(ka >> 16); aidx[rb16 + ra_] = ia; bval[rb16 + rb_] = f16key_val(kb >> 16); bidx[rb16 + rb_] = ib;
            av = aval[lane]; ai = aidx[lane]; bv = bval[lane]; bi = bidx[lane];
        }
        const float a0 = aval[rb16], b0 = bval[rb16], a2 = aval[rb16 + ci2], b2 = bval[rb16 + cj2], a3 = aval[rb16 + ((5 + li) & 15)], b1 = bval[rb16 + 1];
        unsigned e0 = (f32key(a0 + bv) & ~63u) | (unsigned)li;
        unsigned e1 = li >= 1 ? ((f32key(av + b0) & ~63u) | (unsigned)(16 + li)) : 0u;
        unsigned e2 = (f32key(a2 + b2) & ~63u) | (unsigned)(32 + li);
        unsigned e3 = li <= 2 ? ((f32key(a3 + b1) & ~63u) | (unsigned)(48 + li)) : 0u;
        CE(e0, e1); CE(e2, e3); CE(e0, e2); CE(e1, e3); CE(e1, e2);
        unsigned mine = 0u;
#pragma unroll
        for (int r = 0; r < 16; ++r) {
            const unsigned M = row16_maxu(e0);
            if (li == r) mine = M;
            if (e0 == M) { e0 = e1; e1 = e2; e2 = e3; e3 = 0u; }
        }
        const int sub = (int)((mine >> 4) & 3u), sl = (int)(mine & 15u);
        const int si2 = sl <= 6 ? 1 : (sl <= 10 ? 2 : (sl <= 13 ? 3 : 4)), sj2 = sl <= 6 ? sl + 1 : (sl <= 10 ? sl - 6 : (sl <= 13 ? sl - 10 : sl - 13));
        const int wi = sub == 0 ? 0 : (sub == 1 ? sl : (sub == 2 ? si2 : 5 + sl)), wj = sub == 0 ? sl : (sub == 1 ? 0 : (sub == 2 ? sj2 : 1));
        const float sm = aval[rb16 + wi] + bval[rb16 + wj]; ex[R] = aidx[rb16 + wi] * 128 + bidx[rb16 + wj];
        const unsigned kuv = ((const unsigned*)(F.ws + WS_KUV))[ex[R]];
        const float mx = row16_max(sm);
        const float ee = __expf(rstd2 * (sm - mx));
        gt[R] = ldexpf(ee / row16_sum(ee), 64 - (int)((kuv >> 8) & 0xffu));
        exk[R] = (unsigned)ex[R] * 768u | ((kuv & 0xffu) << 24);
    }
    LAS int* cnt = (LAS int*)wsc; LAS int* offs = (LAS int*)(wsc + 64);
    LAS int* sex = (LAS int*)tls; LAS float* sgt = tls + 128;
    cnt[lane] = 0;
    const int s0 = ex[0] >> PEER_SLSH, s1 = ex[1] >> PEER_SLSH;
    const int r0 = __hip_atomic_fetch_add(&cnt[s0], 1, __ATOMIC_RELAXED, __HIP_MEMORY_SCOPE_WORKGROUP);
    const int r1 = __hip_atomic_fetch_add(&cnt[s1], 1, __ATOMIC_RELAXED, __HIP_MEMORY_SCOPE_WORKGROUP);
    const int c0 = cnt[lane]; int c = c0;
#pragma unroll
    for (int o = 1; o < 64; o <<= 1) { const int t = __shfl_up(c, o, 64); if (lane >= o) c += t; }
    offs[lane] = c - c0;
    cvec = c;
    const int p0 = offs[s0] + r0, p1 = offs[s1] + r1;
    sex[p0] = (int)exk[0]; sgt[p0] = gt[0]; sex[p1] = (int)exk[1]; sgt[p1] = gt[1];
}
typedef unsigned v6u32 __attribute__((ext_vector_type(6)));
typedef __bf16 v32bf __attribute__((ext_vector_type(32)));
typedef float v32f __attribute__((ext_vector_type(32)));
__device__ __forceinline__ void peer_batch(const unsigned char* U6, const unsigned char* V6, int lane, int b, const LAS float* tls, float (&acc)[16]) {
    const LAS unsigned* sex = (const LAS unsigned*)tls; const LAS float* sgt = tls + 128;
    typedef unsigned v2u32_t __attribute__((ext_vector_type(2)));
    typedef unsigned v3u32_t __attribute__((ext_vector_type(3)));
    const __amdgpu_buffer_rsrc_t ru = __builtin_amdgcn_make_buffer_rsrc((void*)U6, 0, 0x7fffffff, 0x00020000);
    const __amdgpu_buffer_rsrc_t rv = __builtin_amdgcn_make_buffer_rsrc((void*)V6, 0, 0x7fffffff, 0x00020000);
    const int lofs = 12 * lane;
    v6u32 pku[4], pkv[4];
#pragma unroll
    for (int jj = 0; jj < 4; ++jj) {
        const int e0 = (int)((unsigned)__builtin_amdgcn_readfirstlane((int)sex[8 * b + 2 * jj]) & 0xffffffu), e1 = (int)((unsigned)__builtin_amdgcn_readfirstlane((int)sex[8 * b + 2 * jj + 1]) & 0xffffffu);
        { const v3u32_t a = __builtin_amdgcn_raw_buffer_load_b96(ru, lofs, e0, 0); const unsigned bx = __builtin_amdgcn_raw_buffer_load_b32(ru, lofs, e1, 0); const v2u32_t byz = __builtin_amdgcn_raw_buffer_load_b64(ru, lofs + 4, e1, 0);
          pku[jj] = (v6u32){a.x, a.y, a.z, bx, byz.x, byz.y}; }
        { const v3u32_t a = __builtin_amdgcn_raw_buffer_load_b96(rv, lofs, e0, 0); const unsigned bx = __builtin_amdgcn_raw_buffer_load_b32(rv, lofs, e1, 0); const v2u32_t byz = __builtin_amdgcn_raw_buffer_load_b64(rv, lofs + 4, e1, 0);
          pkv[jj] = (v6u32){a.x, a.y, a.z, bx, byz.x, byz.y}; }
    }
    unsigned hp[8];
#pragma unroll
    for (int k = 0; k < 8; ++k) hp[k] = ((const LAS unsigned*)tls)[256 + k * 64 + lane];
    float d[8];
#pragma unroll
    for (int jj = 0; jj < 4; ++jj) {
        const v32bf r = __builtin_amdgcn_cvt_scalef32_pk32_bf16_fp6(pku[jj], 1.0f);
        float s0 = 0.f, s1 = 0.f;
#pragma unroll
        for (int k = 0; k < 8; ++k) {
            const bf16x2v x0 = {r[2 * k], r[2 * k + 1]}, x1 = {r[16 + 2 * k], r[17 + 2 * k]};
            s0 = __builtin_amdgcn_fdot2_f32_bf16(x0, __builtin_bit_cast(bf16x2v, hp[k]), s0, false);
            s1 = __builtin_amdgcn_fdot2_f32_bf16(x1, __builtin_bit_cast(bf16x2v, hp[k]), s1, false);
        }
        d[2 * jj] = s0; d[2 * jj + 1] = s1;
    }
    float t4[4], t2[2], t1;
    { const bool up = lane & 4;
#pragma unroll
      for (int k = 0; k < 4; ++k) { const float keep = up ? d[4 + k] : d[k], send = up ? d[k] : d[4 + k]; t4[k] = keep + dppf<0x141>(send); } }
    { const bool up = lane & 1;
#pragma unroll
      for (int k = 0; k < 2; ++k) { const float keep = up ? t4[2 + k] : t4[k], send = up ? t4[k] : t4[2 + k]; t2[k] = keep + dppf<0xB1>(send); } }
    { const bool up = lane & 2; const float keep = up ? t2[1] : t2[0], send = up ? t2[0] : t2[1]; t1 = keep + dppf<0x4E>(send); }
    t1 += dppf<0x128>(t1);
    { auto r = __builtin_amdgcn_permlane16_swap(__float_as_uint(t1), __float_as_uint(t1), false, false); const unsigned r0 = r[0], r1 = r[1]; t1 = __uint_as_float(r0) + __uint_as_float(r1); }
    { auto r = __builtin_amdgcn_permlane32_swap(__float_as_uint(t1), __float_as_uint(t1), false, false); const unsigned r0 = r[0], r1 = r[1]; t1 = __uint_as_float(r0) + __uint_as_float(r1); }
    const int myj = 4 * ((lane >> 2) & 1) + 2 * (lane & 1) + ((lane >> 1) & 1);
    const float g = sgt[8 * b + myj];
    const int ku = (int)(sex[8 * b + myj] >> 24) - 64;
    const float coef = g * gelu_erf(ldexpf(t1, -ku));
#pragma unroll
    for (int jj = 0; jj < 4; ++jj) {
        const int j0 = 2 * jj, j1 = 2 * jj + 1;
        const int src0 = 4 * (j0 >> 2) + ((j0 >> 1) & 1) + 2 * (j0 & 1), src1 = 4 * (j1 >> 2) + ((j1 >> 1) & 1) + 2 * (j1 & 1);
        const float c0 = __builtin_bit_cast(float, __builtin_amdgcn_readlane(__builtin_bit_cast(int, coef), src0));
        const float c1 = __builtin_bit_cast(float, __builtin_amdgcn_readlane(__builtin_bit_cast(int, coef), src1));
        const v32f r = __builtin_amdgcn_cvt_scalef32_pk32_f32_fp6(pkv[jj], 1.0f);
#pragma unroll
        for (int i = 0; i < 16; ++i) { acc[i] = __builtin_fmaf(c0, r[i], acc[i]); acc[i] = __builtin_fmaf(c1, r[16 + i], acc[i]); }
        __builtin_amdgcn_sched_barrier(0);
    }
}
__device__ __forceinline__ void peer_finish(Frame& F, int tok, const float (&acc)[16]) {
    const int lane = F.lane; const float* fin_norm = F.in[12];
    float* orow = F.out + (size_t)tok * DMODEL; const u16* xrow = (const u16*)(F.ws + WS_X1B) + (size_t)tok * DMODEL;
    f32x4 o[4]; float s2 = 0.f;
    { unsigned w[8];
#pragma unroll
      for (int q = 0; q < 4; ++q) { const u32x2 t = *(const u32x2*)(xrow + 256 * q + 4 * lane); w[2 * q] = t.x; w[2 * q + 1] = t.y; }
#pragma unroll
      for (int q = 0; q < 4; ++q) { o[q][0] = bf2f(w[2 * q] & 0xffffu); o[q][1] = bf2f(w[2 * q] >> 16); o[q][2] = bf2f(w[2 * q + 1] & 0xffffu); o[q][3] = bf2f(w[2 * q + 1] >> 16); } }
#pragma unroll
    for (int q = 0; q < 4; ++q)
#pragma unroll
        for (int j = 0; j < 4; ++j) { o[q][j] += acc[4 * q + j]; s2 += o[q][j] * o[q][j]; }
    const float rs = 1.0f / sqrtf(wave_sum(s2) * (1.f / DMODEL) + EPS);
#pragma unroll
    for (int q = 0; q < 4; ++q) { const f32x4 fn = *(const f32x4*)(fin_norm + 256 * q + 4 * lane); f32x4 r;
#pragma unroll
        for (int j = 0; j < 4; ++j) r[j] = o[q][j] * rs * fn[j];
        *(f32x4*)(orow + 256 * q + 4 * lane) = r; }
}
constexpr int CW_PQ = 7680;
__device__ __forceinline__ unsigned peer_group(Frame& F, int g, LAS float* wsc, unsigned* q) {
    const unsigned char* U8 = (const unsigned char*)(F.ws + WS_U); const unsigned char* V8 = (const unsigned char*)(F.ws + WS_V);
    int cvec[PEER_T]; float acc[PEER_T][16]; int nb[PEER_T];
#pragma unroll
    for (int t = 0; t < PEER_T; ++t) { peer_route(F, g * PEER_T + t, wsc, wsc + 320 + t * 768, cvec[t]); nb[t] = 0;
#pragma unroll
        for (int i = 0; i < 16; ++i) acc[t][i] = 0.f; }
#pragma unroll 1
    for (int s = 0; s < PEER_NSL; ++s) {
#pragma unroll
        for (int t = 0; t < PEER_T; ++t) {
            const int cs = __builtin_amdgcn_readlane(cvec[t], s);
            while (8 * (nb[t] + 1) <= cs) { peer_batch(U8, V8, F.lane, nb[t], wsc + 320 + t * 768, acc[t]); ++nb[t]; }
        }
    }
    unsigned tk = 0u;
    if (q) { if (F.lane == 0) tk = xb_add(q, 1u); }
#pragma unroll
    for (int t = 0; t < PEER_T; ++t) peer_finish(F, g * PEER_T + t, acc[t]);
    return (unsigned)__builtin_amdgcn_readfirstlane((int)tk);
}

#ifndef MK_N_LAUNCHES
#define MK_N_LAUNCHES 1
#endif
constexpr int N_PHASES = 9;
constexpr int N_LAUNCHES = MK_N_LAUNCHES;
constexpr int CW_BAR = 4096;

struct Args { const float* in[13]; float* out; unsigned char* ws; int ph_lo, ph_hi, li, pad; };

__global__ void __launch_bounds__(NWAVES * 64, 2) mk_fwd(Args args) {
    extern __shared__ __attribute__((aligned(16))) unsigned char lds[];
    Frame F;
    F.lds = (LAS unsigned char*)lds; F.ldsg = lds;
    F.tid = threadIdx.x; F.lane = F.tid & 63; F.wave = __builtin_amdgcn_readfirstlane(F.tid >> 6);
    F.G = gridDim.x; { const int bx = blockIdx.x; F.vcu = (F.G % 8 == 0) ? (bx % 8) * (F.G / 8) + bx / 8 : bx; }
#pragma unroll
    for (int i = 0; i < 13; ++i) F.in[i] = args.in[i];
    F.out = args.out; F.ws = args.ws;
    volatile LAS unsigned* MISC = (volatile LAS unsigned*)(F.lds + MISC_OFF);
    for (int u = F.tid; u < (LDS_BYTES - LDSCTL_OFF) / 4; u += NWAVES * 64) ((LAS unsigned*)(F.lds + LDSCTL_OFF))[u] = 0u;
    __syncthreads();
    unsigned* ctl = (unsigned*)(F.ws + WS_CTL);
    XcdBarrier bar; bar.bar = ctl + CW_BAR; bar.x = 0; bar.st = nullptr;
    if (N_LAUNCHES == 1) bar = xcd_barrier_post(ctl + CW_BAR, MISC + 8);
    const int lo = args.ph_lo, hi = args.ph_hi;
#ifndef PH_MASK
#define PH_MASK 0x1FF
#endif
#define IN(k) (((PH_MASK >> (k)) & 1) && lo <= (k) && (k) < hi)
#define SEAM(k) do { if (IN(k) && IN((k) + 1)) xcd_barrier(bar); } while (0)

    if (IN(0)) { p0_prologue(F); }
    SEAM(0);
    if (IN(1)) {
        pg8::Desc S{}; S.A0 = (const u16*)(F.ws + WS_XB); S.B0 = (const u16*)(F.ws + WS_WIN); S.A1 = S.A0; S.B1 = S.B0;
        S.K = 1024; S.nM = NTOK / 256; S.nN = N1PAD / 256; S.nsub = 1; S.G = F.G; S.c = (int)blockIdx.x; S.mode = pg8::M_PROJ; S.ws = F.ws; S.xin = nullptr; S.out = nullptr;
        pg8::gemm_phase(F.lds + RING_OFF, S);
    }
    SEAM(1);
    if (IN(2)) {
        if (F.G == 256) {
            const int xcd = F.vcu >> 5, wi = F.vcu & 31, b = xcd >> 1, half = xcd & 1;
#define IDX_GRP_A(k) (b * 1024 + (127 - (((k) * 64 + half * 32 + wi) >> 3)) * 8 + (((k) * 64 + half * 32 + wi) & 7))
            IdxPre P; idx_prefetch(F, IDX_GRP_A(0), P);
            for (int k = 0; k < 16; ++k) indexer_group(F, IDX_GRP_A(k), IDX_GRP_A(k < 15 ? k + 1 : k), P);
#undef IDX_GRP_A
        } else {
#define IDX_GRP_B(i) (((i) & 31) >> 3) * 1024 + (127 - ((i) >> 5)) * 8 + ((i) & 7)
            if (F.vcu < 4096) { IdxPre P; idx_prefetch(F, IDX_GRP_B(F.vcu), P);
                for (int i = F.vcu; i < 4096; i += F.G) indexer_group(F, IDX_GRP_B(i), IDX_GRP_B(i + F.G < 4096 ? i + F.G : i), P); }
#undef IDX_GRP_B
        }
        __syncthreads();
        for (int g = F.vcu; g < 256; g += F.G) ret_kv_group(F, g);
        __syncthreads();
    }
    SEAM(2);
    if (IN(3)) { ret_scan(F); }
    SEAM(3);
    if (IN(4)) {
        if (F.tid < 64) { const int e = F.tid >> 2, j = F.tid & 3; ((LAS float*)(F.lds + attn_body::LDS_TBL))[F.tid] = ((e >> j) & 1) ? 0.f : -INFINITY; }
        __syncthreads();
        const attn_body::bf16* Qp = (const attn_body::bf16*)(F.ws + WS_DQ); const attn_body::bf16* Kp = (const attn_body::bf16*)(F.ws + WS_DK); const attn_body::bf16* Vp = (const attn_body::bf16*)(F.ws + WS_DV);
        attn_body::bf16* Op = (attn_body::bf16*)(F.ws + WS_YDSA);
        const unsigned long long* BMp = (const unsigned long long*)((unsigned char*)F.out + OUT_BM);
        for (int v = F.vcu; v < 256; v += F.G) {
            const int s = v & 7, bh = v >> 3;
#pragma unroll 1
            for (int i = 0; i < 4; ++i) { const int qb = (i == 0) ? s : (i == 1) ? 15 - s : (i == 2) ? 16 + s : 31 - s;
                attn_body::attn_unit<8>(bh >> 3, bh & 7, qb, Qp, Kp, Vp, Op, BMp, (char*)lds + RING_OFF); }
        }
        __syncthreads();
        for (int g = F.vcu; g < 256; g += F.G) ret_out_group(F, g);
        __syncthreads();
    }
    SEAM(4);
    if (IN(5)) {
        pg8::Desc S{}; S.A0 = (const u16*)(F.ws + WS_YRET); S.B0 = (const u16*)(F.ws + WS_WRO); S.A1 = (const u16*)(F.ws + WS_YDSA); S.B1 = (const u16*)(F.ws + WS_WDO);
        S.K = 512; S.nM = NTOK / 256; S.nN = 4; S.nsub = 2; S.G = F.G; S.c = (int)blockIdx.x; S.mode = pg8::M_MERGE; S.ws = F.ws; S.xin = nullptr; S.out = nullptr;
        pg8::gemm_phase(F.lds + RING_OFF, S);
    }
    SEAM(5);
    if (IN(6)) {
        pg8::Desc S{}; S.A0 = (const u16*)(F.ws + WS_MERGED); S.B0 = (const u16*)(F.ws + WS_WOUT); S.A1 = S.A0; S.B1 = S.B0;
        S.K = 1024; S.nM = NTOK / 256; S.nN = 4; S.nsub = 1; S.G = F.G; S.c = (int)blockIdx.x; S.mode = pg8::M_OUT; S.ws = F.ws; S.xin = F.in[0]; S.out = F.out;
        pg8::gemm_phase(F.lds + RING_OFF, S);
    }
    SEAM(6);
    if (IN(7)) {
        pg8::Desc S{}; S.A0 = (const u16*)(F.ws + WS_X1B); S.B0 = (const u16*)(F.ws + WS_WSC); S.A1 = S.A0; S.B1 = S.B0;
        S.K = 1024; S.nM = NTOK / 256; S.nN = 8; S.nsub = 1; S.G = F.G; S.c = (int)blockIdx.x; S.mode = pg8::M_SCORE; S.ws = F.ws; S.xin = nullptr; S.out = nullptr;
        pg8::gemm_phase(F.lds + RING_OFF, S);
    }
    SEAM(7);
    if (IN(8)) {
        LAS float* wsc = (LAS float*)(F.lds + F.wave * PEER_WSC);
        const int gw = F.vcu * NWAVES + F.wave, NGW = F.G * NWAVES;
        if (N_LAUNCHES == 1 && NGW <= NTOK / PEER_T) {
            unsigned* q = ctl + CW_PQ;
            int g = gw;
            while (g < NTOK / PEER_T) { const unsigned tk = peer_group(F, g, wsc, q); g = NGW + (int)tk; }
        } else {
            for (int g = gw; g < NTOK / PEER_T; g += NGW) (void)peer_group(F, g, wsc, nullptr);
        }
    }
#undef IN
#undef SEAM
}

extern "C" void kernel_launch(void* const* d_in, const int* in_sizes, int n_in, void* d_out, int out_size, void* d_ws, size_t ws_size, hipStream_t stream) {
    static int grid = 0;
    if (grid == 0) {
        if (n_in != 13 || in_sizes[0] != NTOK * DMODEL || out_size != NTOK * DMODEL || ws_size < WS_END) {
            fprintf(stderr, "kernel_launch: unexpected shapes (n_in %d, in0 %d, out %d, ws %zu)\n", n_in, n_in > 0 ? in_sizes[0] : -1, out_size, ws_size); grid = -1; return; }
        int dev = 0, cus = 0, per_cu = 0;
        if (hipGetDevice(&dev) != hipSuccess || hipDeviceGetAttribute(&cus, hipDeviceAttributeMultiprocessorCount, dev) != hipSuccess) { grid = -1; return; }
        if (hipFuncSetAttribute((const void*)mk_fwd, hipFuncAttributeMaxDynamicSharedMemorySize, LDS_BYTES) != hipSuccess) { fprintf(stderr, "kernel_launch: hipFuncSetAttribute failed\n"); grid = -1; return; }
        if (hipOccupancyMaxActiveBlocksPerMultiprocessor(&per_cu, (const void*)mk_fwd, NWAVES * 64, LDS_BYTES) != hipSuccess || per_cu < 1) {
            fprintf(stderr, "kernel_launch: occupancy query reports %d workgroups per CU\n", per_cu); }
        (void)hipGetLastError();
        grid = cus;
    }
    if (grid < 0) return;
    if (hipMemsetAsync((char*)d_ws + WS_CTL, 0, CTL_ZERO_BYTES, stream) != hipSuccess) return;
    Args a{};
    for (int i = 0; i < 13; ++i) a.in[i] = (const float*)d_in[i];
    a.out = (float*)d_out; a.ws = (unsigned char*)d_ws;
    for (int li = 0; li < N_LAUNCHES; ++li) {
        a.ph_lo = (N_LAUNCHES == 1) ? 0 : li; a.ph_hi = (N_LAUNCHES == 1) ? N_PHASES : li + 1; a.li = li; a.pad = 0;
        hipLaunchKernelGGL(mk_fwd, dim3(grid), dim3(NWAVES * 64), LDS_BYTES, stream, a);
    }
}
```
